# Optimizing an MI355X kernel written in HIP

```python
import jax, jax.numpy as jnp
from jax import lax
import numpy as np

D_MODEL = 1024
BATCH = 16
SEQ = 256
DEPTH = 4
DEC_BATCH = 2
DEC_SEQ = 1024
PAST_LEN = 512

GRID_W = 64
HEAD_DIM = 64
N_Q_HEADS = 8
N_KV_HEADS = 2
GROUP = N_Q_HEADS // N_KV_HEADS
ATT_W = N_Q_HEADS * HEAD_DIM
KV_W = N_KV_HEADS * HEAD_DIM
N_FREQ = HEAD_DIM // 4
ROPE_THETA = 10000.0
CONV_W = 512
POOL_W = 512
POOL_SIZES = (2, 4, 8, 16)
POOL_GROUPS = 4
POOL_GC = POOL_W // POOL_GROUPS
N_BRANCH = 4
BRANCH_W = 512
D_FF = -(-(8 * D_MODEL) // (3 * 256)) * 256
BLOCK = 128
WINDOW = 128
EPS = 1e-6
NEG = -1e30

kernel_name = "hybrid_diffusion_prefix_trunk_step"


def _rmsnorm(x, g):
    xf = x.astype(jnp.float32)
    y = xf * lax.rsqrt(jnp.mean(xf * xf, axis=-1, keepdims=True) + EPS)
    return (y * g.astype(jnp.float32)).astype(x.dtype)


def _rope_tables(T):
    rows = T // GRID_W
    row = jnp.repeat(jnp.arange(rows, dtype=jnp.float32), GRID_W)
    col = jnp.tile(jnp.arange(GRID_W, dtype=jnp.float32), rows)
    inv = 1.0 / (ROPE_THETA ** (jnp.arange(N_FREQ, dtype=jnp.float32) / N_FREQ))
    ang = jnp.stack([row[:, None] * inv, col[:, None] * inv], axis=1)
    return jnp.cos(ang)[:, None], jnp.sin(ang)[:, None]


def _rope(x, cos, sin):
    B, T, H, _ = x.shape
    xr = x.astype(jnp.float32).reshape(B, T, H, 2, 2, N_FREQ)
    x1, x2 = xr[..., 0, :], xr[..., 1, :]
    out = jnp.stack([x1 * cos - x2 * sin, x2 * cos + x1 * sin], axis=-2)
    return out.reshape(B, T, H, HEAD_DIM).astype(x.dtype)


def _attend(q, k, v, mask=None, sink=None):
    B, Tq = q.shape[:2]
    qg = q.reshape(B, Tq, N_KV_HEADS, GROUP, HEAD_DIM)
    s = jnp.einsum('bqkgd,bskd->bkgqs', qg, k, preferred_element_type=jnp.float32) * (HEAD_DIM ** -0.5)
    if mask is not None:
        s = jnp.where(mask, s, NEG)
    if sink is not None:
        sk = jnp.broadcast_to(sink.astype(jnp.float32).reshape(1, N_KV_HEADS, GROUP, 1, 1), s.shape[:-1] + (1,))
        p = jax.nn.softmax(jnp.concatenate([s, sk], axis=-1), axis=-1)[..., :-1]
    else:
        p = jax.nn.softmax(s, axis=-1)
    o = jnp.einsum('bkgqs,bskd->bqkgd', p.astype(v.dtype), v)
    return o.reshape(B, Tq, N_Q_HEADS * HEAD_DIM)


def _blocked(q, fn):
    B, T = q.shape[:2]
    nb = T // BLOCK
    qb = q.reshape((B, nb, BLOCK) + q.shape[2:]).swapaxes(0, 1)
    out = lax.map(lambda a: fn(a[0], a[1]), (jnp.arange(nb), qb))
    return out.swapaxes(0, 1).reshape(B, T, -1)


def _windowed(q, k, v, ck, cv, sink):
    B, T = q.shape[:2]
    S_c = ck.shape[1]
    pad = ((0, 0), (BLOCK, BLOCK), (0, 0), (0, 0))
    kp, vp = jnp.pad(k, pad), jnp.pad(v, pad)
    offs = jnp.arange(3 * BLOCK) - BLOCK
    qoff = jnp.arange(BLOCK)
    ctx_ok = jnp.ones((BLOCK, S_c), dtype=bool)

    def blk(i, qb):
        kb = lax.dynamic_slice_in_dim(kp, i * BLOCK, 3 * BLOCK, axis=1)
        vb = lax.dynamic_slice_in_dim(vp, i * BLOCK, 3 * BLOCK, axis=1)
        qpos = i * BLOCK + qoff
        kpos = i * BLOCK + offs
        band = (jnp.abs(qpos[:, None] - kpos[None, :]) <= WINDOW) & ((kpos >= 0) & (kpos < T))[None, :]
        mask = jnp.concatenate([ctx_ok, band], axis=1)
        return _attend(qb, jnp.concatenate([ck, kb], axis=1), jnp.concatenate([cv, vb], axis=1), mask, sink)

    return _blocked(q, blk)


def _short_conv(u, gb, gc, conv_w):
    z = gc * u
    T = z.shape[1]
    zp = jnp.pad(z, ((0, 0), (1, 1), (0, 0)))
    y = zp[:, :T] * conv_w[0] + zp[:, 1:T + 1] * conv_w[1] + zp[:, 2:] * conv_w[2]
    return gb * y


def _pool_mix(p, pool_w, pool_scale):
    B, T, _ = p.shape
    pf = p.astype(jnp.float32).reshape(B, T, POOL_GROUPS, POOL_GC)
    cs = jnp.concatenate([jnp.zeros((B, 1, POOL_GROUPS, POOL_GC), jnp.float32), jnp.cumsum(pf, axis=1)], axis=1)
    t = jnp.arange(T)
    means = []
    for g, w in enumerate(POOL_SIZES):
        lo = jnp.clip(t - w // 2, 0, T)
        hi = jnp.clip(t + w - w // 2, 0, T)
        means.append((cs[:, hi, g] - cs[:, lo, g]) / (hi - lo).astype(jnp.float32)[None, :, None])
    y = (jnp.stack(means, axis=2) - pf).astype(p.dtype)
    y = jnp.einsum('btgc,gce->btge', y, pool_w).reshape(B, T, POOL_W)
    return y * pool_scale


def _project(h, w_in, gq_a, gk_a, gq_c, gk_c):
    B, T, _ = h.shape
    sizes = [ATT_W, KV_W, KV_W, ATT_W, KV_W, KV_W, CONV_W, CONV_W, CONV_W, POOL_W, N_BRANCH * D_MODEL]
    idx = np.cumsum(sizes)[:-1].tolist()
    qa, ka, va, qc, kc, vc, u, gb, gc, pv, gl = jnp.split(h @ w_in, idx, axis=-1)
    heads = lambda t, n: t.reshape(B, T, n, HEAD_DIM)
    qa = _rmsnorm(heads(qa, N_Q_HEADS), gq_a)
    ka = _rmsnorm(heads(ka, N_KV_HEADS), gk_a)
    qc = _rmsnorm(heads(qc, N_Q_HEADS), gq_c)
    kc = _rmsnorm(heads(kc, N_KV_HEADS), gk_c)
    va = heads(va, N_KV_HEADS)
    vc = heads(vc, N_KV_HEADS)
    gates = jax.nn.sigmoid(gl.reshape(B, T, N_BRANCH, D_MODEL))
    return qa, ka, va, qc, kc, vc, u, gb, gc, pv, gates


def _layer(x, cond, prm, ctx):
    (w_mod, b_mod, g_mix, g_ffn, w_in, gq_a, gk_a, gq_c, gk_c, sink,
     conv_w, pool_w, pool_scale, w_br, w_o, w_gu, w_down) = prm
    T = x.shape[1]
    mod = jax.nn.silu(cond) @ w_mod + b_mod
    sh1, sc1, g1, sh2, sc2, g2 = [m[:, None, :] for m in jnp.split(mod, 6, axis=-1)]
    h = _rmsnorm(x, g_mix) * (1 + sc1) + sh1
    qa, ka, va, qc, kc, vc, u, gb, gc, pv, gates = _project(h, w_in, gq_a, gk_a, gq_c, gk_c)
    if ctx is None:
        new = (ka, va, kc, vc)
        att_a = _blocked(qa, lambda i, qb: _attend(qb, ka, va))
        att_c = _blocked(qc, lambda i, qb: _attend(qb, kc, vc, sink=sink))
    else:
        cka, cva, ckc, cvc = ctx
        cos, sin = _rope_tables(T)
        qa, ka, qc, kc = (_rope(t, cos, sin) for t in (qa, ka, qc, kc))
        k_all = jnp.concatenate([cka, ka], axis=1)
        v_all = jnp.concatenate([cva, va], axis=1)
        att_a = _blocked(qa, lambda i, qb: _attend(qb, k_all, v_all))
        att_c = _windowed(qc, kc, vc, ckc, cvc, sink)
        new = None
    conv = _short_conv(u, gb, gc, conv_w)
    pool = _pool_mix(pv, pool_w, pool_scale)
    br = jnp.stack([att_a, conv, att_c, pool], axis=2)
    proj = jnp.einsum('btkc,kcd->btkd', br, w_br)
    x = x + g1 * (jnp.sum(gates * proj, axis=2) @ w_o)
    h2 = _rmsnorm(x, g_ffn) * (1 + sc2) + sh2
    a, b = jnp.split(h2 @ w_gu, 2, axis=-1)
    x = x + g2 * ((jax.nn.silu(a) * b) @ w_down)
    return x, new


def setup_inputs(seed: int = 0) -> dict:
    key = jax.random.key(seed)
    ks = jax.random.split(key, 32)
    n = lambda k, s, sc: jax.random.normal(k, s, jnp.float32) * sc
    n_in = 2 * ATT_W + 4 * KV_W + 3 * CONV_W + POOL_W + N_BRANCH * D_MODEL
    cshape = (DEC_BATCH, DEPTH, PAST_LEN, N_KV_HEADS, HEAD_DIM)
    return {
        'x_prompt': n(ks[0], (BATCH, SEQ, D_MODEL), 1.0),
        'x_sample': n(ks[1], (DEC_BATCH, DEC_SEQ, D_MODEL), 1.0),
        'cache_k_attn': n(ks[2], cshape, 1.0),
        'cache_v_attn': n(ks[3], cshape, 1.0),
        'cache_k_win': n(ks[4], cshape, 1.0),
        'cache_v_win': n(ks[5], cshape, 1.0),
        'c': n(ks[6], (DEC_BATCH, D_MODEL), 1.0),
        'c_ctx': n(ks[7], (D_MODEL,), 1.0),
        'w_mod': n(ks[8], (DEPTH, D_MODEL, 6 * D_MODEL), 0.5 * D_MODEL ** -0.5),
        'b_mod': n(ks[9], (DEPTH, 6 * D_MODEL), 0.01),
        'g_mix': 1.0 + n(ks[10], (DEPTH, D_MODEL), 0.02),
        'g_ffn': 1.0 + n(ks[11], (DEPTH, D_MODEL), 0.02),
        'w_in': n(ks[12], (DEPTH, D_MODEL, n_in), D_MODEL ** -0.5),
        'gq_attn': 1.0 + n(ks[13], (DEPTH, HEAD_DIM), 0.02),
        'gk_attn': 1.0 + n(ks[14], (DEPTH, HEAD_DIM), 0.02),
        'gq_win': 1.0 + n(ks[15], (DEPTH, HEAD_DIM), 0.02),
        'gk_win': 1.0 + n(ks[16], (DEPTH, HEAD_DIM), 0.02),
        'sink_win': n(ks[17], (DEPTH, N_Q_HEADS), 0.5),
        'conv_w': n(ks[18], (DEPTH, 3, CONV_W), 3 ** -0.5),
        'pool_w': n(ks[19], (DEPTH, POOL_GROUPS, POOL_GC, POOL_GC), POOL_GC ** -0.5),
        'pool_scale': 1.0 + n(ks[20], (DEPTH, POOL_W), 0.1),
        'w_branch': n(ks[21], (DEPTH, N_BRANCH, BRANCH_W, D_MODEL), BRANCH_W ** -0.5),
        'w_out': n(ks[22], (DEPTH, D_MODEL, D_MODEL), D_MODEL ** -0.5),
        'w_gate_up': n(ks[23], (DEPTH, D_MODEL, 2 * D_FF), D_MODEL ** -0.5),
        'w_down': n(ks[24], (DEPTH, D_FF, D_MODEL), D_FF ** -0.5),
    }


def reference(x_prompt, x_sample, cache_k_attn, cache_v_attn, cache_k_win, cache_v_win, c, c_ctx,
              w_mod, b_mod, g_mix, g_ffn, w_in, gq_attn, gk_attn, gq_win, gk_win, sink_win,
              conv_w, pool_w, pool_scale, w_branch, w_out, w_gate_up, w_down):
    cond_ctx = jnp.broadcast_to(c_ctx, (x_prompt.shape[0], c_ctx.shape[0]))
    xp, xs = x_prompt, x_sample
    ka_l, va_l, kc_l, vc_l = [], [], [], []
    for l in range(DEPTH):
        prm = (w_mod[l], b_mod[l], g_mix[l], g_ffn[l], w_in[l], gq_attn[l], gk_attn[l],
               gq_win[l], gk_win[l], sink_win[l], conv_w[l], pool_w[l], pool_scale[l],
               w_branch[l], w_out[l], w_gate_up[l], w_down[l])
        xp, (ka, va, kc, vc) = _layer(xp, cond_ctx, prm, None)
        ka_l.append(ka)
        va_l.append(va)
        kc_l.append(kc)
        vc_l.append(vc)
        ctx = (cache_k_attn[:, l], cache_v_attn[:, l], cache_k_win[:, l], cache_v_win[:, l])
        xs, _ = _layer(xs, c, prm, ctx)
    k_attn = jnp.stack(ka_l, axis=1)
    v_attn = jnp.stack(va_l, axis=1)
    k_win = jnp.stack(kc_l, axis=1)
    v_win = jnp.stack(vc_l, axis=1)
    return (xp, xs, k_attn, v_attn, k_win, v_win)
```

```cpp
#include <hip/hip_runtime.h>
#include <hip/hip_cooperative_groups.h>
#include <cstdio>
#include <cstdint>
#include <cstring>
namespace cg = cooperative_groups;

#ifndef MK_MULTI
#define MK_MULTI 1
#endif

typedef unsigned short bf16_t;
typedef short bf16x8 __attribute__((ext_vector_type(8)));
typedef short s16x4 __attribute__((ext_vector_type(4)));
typedef float f32x16 __attribute__((ext_vector_type(16)));
typedef float f32x4 __attribute__((ext_vector_type(4)));
typedef unsigned u32x4 __attribute__((ext_vector_type(4)));
typedef unsigned u32x2 __attribute__((ext_vector_type(2)));
#define DI __device__ __forceinline__
#define LAS __attribute__((address_space(3)))

constexpr int NTOK = 6144, NCTX = 4096, DM = 1024, NIN = 7680, NPR = 3584, DFF = 2816, NL = 4;
constexpr float LOG2E = 1.4426950408889634f;
constexpr float QSCALE = 0.125f * LOG2E;
constexpr size_t OUT_KA = 6291456, OUT_VA = 8388608, OUT_KW = 10485760, OUT_VW = 12582912;
constexpr int NPHASE = 1 + 9 * NL;

constexpr size_t al256(size_t x) { return (x + 255) & ~(size_t)255; }
constexpr size_t OFF_bar = 0;
constexpr size_t OFF_mod = OFF_bar + al256(16384);
constexpr size_t OFF_rope = OFF_mod + al256((size_t)NL * 3 * 6144 * 4);
constexpr size_t OFF_WinT = OFF_rope + al256(2048 * 4);
constexpr size_t OFF_WbrT = OFF_WinT + al256((size_t)NL * NIN * DM * 2);
constexpr size_t OFF_WoT = OFF_WbrT + al256((size_t)NL * DM * 2048 * 2);
constexpr size_t OFF_WguT = OFF_WoT + al256((size_t)NL * DM * DM * 2);
constexpr size_t OFF_WdT = OFF_WguT + al256((size_t)NL * 2 * DFF * DM * 2);
constexpr size_t OFF_PoolT = OFF_WdT + al256((size_t)NL * DM * DFF * 2);
constexpr size_t OFF_h = OFF_PoolT + al256((size_t)NL * 4 * 128 * 128 * 2);
constexpr size_t OFF_P = OFF_h + al256((size_t)NTOK * DM * 2);
constexpr size_t OFF_gates = OFF_P + al256((size_t)NTOK * NPR * 4);
constexpr size_t OFF_qA = OFF_gates + al256((size_t)NTOK * 4096 * 2);
constexpr size_t OFF_qC = OFF_qA + al256((size_t)NTOK * 512 * 2);
constexpr size_t OFF_kAc = OFF_qC + al256((size_t)NTOK * 512 * 2);
constexpr size_t OFF_kCc = OFF_kAc + al256((size_t)NCTX * 128 * 2);
constexpr size_t OFF_kAl = OFF_kCc + al256((size_t)NCTX * 128 * 2);
constexpr size_t OFF_kCl = OFF_kAl + al256((size_t)NL * 2 * 1536 * 128 * 2);
constexpr size_t OFF_vAcT = OFF_kCl + al256((size_t)NL * 2 * 1536 * 128 * 2);
constexpr size_t OFF_vCcT = OFF_vAcT + al256((size_t)NCTX * 128 * 2);
constexpr size_t OFF_vAlT = OFF_vCcT + al256((size_t)NCTX * 128 * 2);
constexpr size_t OFF_vClT = OFF_vAlT + al256((size_t)NL * 2 * 1536 * 128 * 2);
constexpr size_t OFF_ypool = OFF_vClT + al256((size_t)NL * 2 * 1536 * 128 * 2);
constexpr size_t OFF_br = OFF_ypool + al256((size_t)NTOK * 512 * 2);
constexpr size_t OFF_merged = OFF_br + al256((size_t)NTOK * 2048 * 2);
constexpr size_t OFF_act = OFF_merged + al256((size_t)NTOK * DM * 2);
constexpr size_t WS_TOTAL = OFF_act + al256((size_t)NTOK * DFF * 2);

struct Ctx { int tid, bid; };
struct Params {
    const float *x_prompt, *x_sample, *ck_a, *cv_a, *ck_w, *cv_w, *c, *c_ctx;
    const float *w_mod, *b_mod, *g_mix, *g_ffn, *w_in, *gq_a, *gk_a, *gq_c, *gk_c, *sink, *conv_w, *pool_w, *pool_scale, *w_br, *w_o, *w_gu, *w_down;
    float* out;
    unsigned char* ws;
    int phase_lo, phase_hi;
};

DI bf16_t f2bf(float x) { return __builtin_bit_cast(unsigned short, (__bf16)x); }
DI float bf2f(bf16_t v) { return __uint_as_float(((unsigned)v) << 16); }
DI unsigned pack2(float lo, float hi) {
    typedef __bf16 bf2 __attribute__((ext_vector_type(2)));
    typedef float f2 __attribute__((ext_vector_type(2)));
    f2 x = {lo, hi};
    return __builtin_bit_cast(unsigned, __builtin_convertvector(x, bf2));
}
DI float wave_sum(float v) {
#pragma unroll
    for (int o = 32; o >= 1; o >>= 1) v += __shfl_xor(v, o);
    return v;
}
DI int condrow(int r) { return r < NCTX ? 0 : 1 + ((r - NCTX) >> 10); }

#define XB_TMO      128
#define XB_XCNT(j)  (256  + 64 * (j))
#define XB_XSUB(j)  (1280 + 64 * (j))
#define XB_XGEN(j)  (2304 + 64 * (j))
#define XB_TOP      3328
#define XB_TOPGEN   3392
#define XCD_BAR_WORDS 3456
#define XB_SPIN_CAP (1u << 22)
DI unsigned xb_ld(unsigned* p) { return __hip_atomic_load(p, __ATOMIC_RELAXED, __HIP_MEMORY_SCOPE_AGENT); }
DI unsigned xb_add(unsigned* p, unsigned v) { return __hip_atomic_fetch_add(p, v, __ATOMIC_RELAXED, __HIP_MEMORY_SCOPE_AGENT); }
DI unsigned xb_xcc_id() { return (unsigned)__builtin_amdgcn_s_getreg((3 << 11) | 20) & 0xFu; }
#define XB_SPIN(cond, bar) do { unsigned _sp = 0; while (cond) { __builtin_amdgcn_s_sleep(1); \
    if ((++_sp & 255u) == 0u) { if (xb_ld(&(bar)[XB_TMO])) break; if (_sp > XB_SPIN_CAP) { atomicAdd(&(bar)[XB_TMO], 1u); break; } } } } while (0)
struct XcdBarrier { unsigned* bar; unsigned x; volatile LAS unsigned* st; };
DI XcdBarrier xcd_barrier_post(unsigned* bar, volatile LAS unsigned* st) {
    XcdBarrier b; b.bar = bar; b.x = xb_xcc_id(); b.st = st;
    if (threadIdx.x == 0) (void)xb_add(&bar[XB_XCNT(b.x)], 1u);
    return b;
}
DI void xcd_barrier_complete(unsigned* bar, unsigned x, unsigned& nloc, unsigned& nx) {
    const unsigned G = gridDim.x * gridDim.y * gridDim.z;
    unsigned sum, cnt, mine, sp = 0u;
    for (;;) {
        sum = 0u; cnt = 0u; mine = 0u;
#pragma unroll
        for (unsigned j = 0; j < 16; ++j) { const unsigned c = xb_ld(&bar[XB_XCNT(j)]); sum += c; cnt += (c > 0u) ? 1u : 0u; mine = (j == x) ? c : mine; }
        if (sum == G) break;
        __builtin_amdgcn_s_sleep(1);
        if ((++sp & 255u) == 0u) { if (xb_ld(&bar[XB_TMO])) break; if (sp > XB_SPIN_CAP) { atomicAdd(&bar[XB_TMO], 1u); break; } }
    }
    nloc = mine > 0u ? mine : 1u; nx = cnt > 0u ? cnt : 1u;
}
DI void xcd_barrier(const XcdBarrier& b) {
    asm volatile("s_waitcnt vmcnt(0)" ::: "memory");
    __syncthreads();
    if (threadIdx.x == 0) {
        unsigned* bar = b.bar;
        __builtin_amdgcn_s_waitcnt(0);
        unsigned nloc = b.st[0], nx = b.st[1];
        if (nloc == 0u) { xcd_barrier_complete(bar, b.x, nloc, nx); b.st[0] = nloc; b.st[1] = nx; }
        const unsigned old = xb_add(&bar[XB_XSUB(b.x)], 1u);
        const unsigned gen = old / nloc;
        if (old + 1u == (gen + 1u) * nloc) {
            __builtin_amdgcn_fence(__ATOMIC_RELEASE, "agent");
            asm volatile("s_waitcnt vmcnt(0)" ::: "memory");
            const unsigned og = xb_add(&bar[XB_TOP], 1u);
            const unsigned tg = og / nx;
            if (og + 1u == (tg + 1u) * nx) xb_add(&bar[XB_TOPGEN], 1u);
            else XB_SPIN(xb_ld(&bar[XB_TOPGEN]) == tg, bar);
            __builtin_amdgcn_fence(__ATOMIC_ACQUIRE, "agent");
            xb_add(&bar[XB_XGEN(b.x)], 1u);
            asm volatile("s_waitcnt vmcnt(0)" ::: "memory");
        } else {
            XB_SPIN(xb_ld(&bar[XB_XGEN(b.x)]) == gen, bar);
            __builtin_amdgcn_fence(__ATOMIC_ACQUIRE, "agent");
            asm volatile("s_waitcnt vmcnt(0)" ::: "memory");
        }
    }
    __syncthreads();
}

DI void transpose_tile(const Ctx& cx, const float* __restrict__ src, int ldsrc, int k0, int n0, bf16_t* __restrict__ dst, int ldd, int dcol0, int drow0, unsigned char* smem) {
    float* T = (float*)smem;
    const int tid = cx.tid;
    const int kk = tid >> 4, c4 = (tid & 15) * 4;
#pragma unroll
    for (int i = 0; i < 4; ++i) {
        const f32x4 v = *(const f32x4*)(src + (size_t)(k0 + kk + 16 * i) * ldsrc + n0 + c4);
        float* t = T + (kk + 16 * i) * 65 + c4;
        t[0] = v[0]; t[1] = v[1]; t[2] = v[2]; t[3] = v[3];
    }
    __syncthreads();
    const int nl = tid >> 2, kq = tid & 3;
    unsigned w[8];
#pragma unroll
    for (int j = 0; j < 8; ++j) w[j] = pack2(T[(kq * 16 + 2 * j) * 65 + nl], T[(kq * 16 + 2 * j + 1) * 65 + nl]);
    bf16_t* d = dst + (size_t)(drow0 + nl) * ldd + dcol0 + k0 + kq * 16;
    *(u32x4*)d = (u32x4){w[0], w[1], w[2], w[3]};
    *(u32x4*)(d + 8) = (u32x4){w[4], w[5], w[6], w[7]};
    __syncthreads();
}

DI void prologue_transpose(const Ctx& cx, const Params& p, int u, unsigned char* smem) {
    const int l = u / 4816; int i = u % 4816;
    if (i < 1920) { const int kt = i & 15, nt = i >> 4;
        transpose_tile(cx, p.w_in + (size_t)l * DM * NIN, NIN, kt * 64, nt * 64, ((bf16_t*)(p.ws + OFF_WinT)) + (size_t)l * NIN * DM, DM, 0, nt * 64, smem); return; }
    i -= 1920;
    if (i < 512) { const int brn = i >> 7; const int j = i & 127; const int kt = j & 7, nt = j >> 3;
        transpose_tile(cx, p.w_br + ((size_t)l * 4 + brn) * 512 * DM, DM, kt * 64, nt * 64, ((bf16_t*)(p.ws + OFF_WbrT)) + (size_t)l * DM * 2048, 2048, brn * 512, nt * 64, smem); return; }
    i -= 512;
    if (i < 256) { const int kt = i & 15, nt = i >> 4;
        transpose_tile(cx, p.w_o + (size_t)l * DM * DM, DM, kt * 64, nt * 64, ((bf16_t*)(p.ws + OFF_WoT)) + (size_t)l * DM * DM, DM, 0, nt * 64, smem); return; }
    i -= 256;
    if (i < 1408) { const int kt = i & 15, nt = i >> 4;
        const int isb = nt >= 44; const int j0 = (nt - (isb ? 44 : 0)) * 64;
        float* T = (float*)smem;
        const int tid = cx.tid; const int kk = tid >> 4, c4 = (tid & 15) * 4;
        const float* src = p.w_gu + (size_t)l * DM * 2 * DFF;
#pragma unroll
        for (int q = 0; q < 4; ++q) {
            const f32x4 v = *(const f32x4*)(src + (size_t)(kt * 64 + kk + 16 * q) * (2 * DFF) + nt * 64 + c4);
            float* t = T + (kk + 16 * q) * 65 + c4;
            t[0] = v[0]; t[1] = v[1]; t[2] = v[2]; t[3] = v[3];
        }
        __syncthreads();
        const int nl = tid >> 2, kq = tid & 3;
        unsigned w[8];
#pragma unroll
        for (int j = 0; j < 8; ++j) w[j] = pack2(T[(kq * 16 + 2 * j) * 65 + nl], T[(kq * 16 + 2 * j + 1) * 65 + nl]);
        const int drow = (j0 >> 5) * 64 + isb * 32 + nl + (nl >= 32 ? 32 : 0);
        bf16_t* d = ((bf16_t*)(p.ws + OFF_WguT)) + (size_t)l * 2 * DFF * DM + (size_t)drow * DM + kt * 64 + kq * 16;
        *(u32x4*)d = (u32x4){w[0], w[1], w[2], w[3]};
        *(u32x4*)(d + 8) = (u32x4){w[4], w[5], w[6], w[7]};
        __syncthreads();
        return; }
    i -= 1408;
    if (i < 704) { const int kt = i % 44, nt = i / 44;
        transpose_tile(cx, p.w_down + (size_t)l * DFF * DM, DM, kt * 64, nt * 64, ((bf16_t*)(p.ws + OFF_WdT)) + (size_t)l * DM * DFF, DFF, 0, nt * 64, smem); return; }
    i -= 704;
    { const int g = i >> 2; const int kt = i & 1, nt = (i >> 1) & 1;
        transpose_tile(cx, p.pool_w + ((size_t)l * 4 + g) * 128 * 128, 128, kt * 64, nt * 64, ((bf16_t*)(p.ws + OFF_PoolT)) + ((size_t)l * 4 + g) * 128 * 128, 128, 0, nt * 64, smem); }
}

DI void prologue_mod(const Ctx& cx, const Params& p, int u, unsigned char* smem) {
    const int l = u / 96, chunk = u % 96;
    const int tid = cx.tid, nn = tid & 63, kq = tid >> 6;
    const int n = chunk * 64 + nn;
    const float* w = p.w_mod + (size_t)l * DM * 6144 + n;
    float s0 = 0.f, s1 = 0.f, s2 = 0.f;
#pragma unroll 8
    for (int k = kq * 256; k < kq * 256 + 256; ++k) {
        const float wv = w[(size_t)k * 6144];
        const float c0 = p.c_ctx[k], c1 = p.c[k], c2 = p.c[DM + k];
        s0 += (c0 / (1.f + __expf(-c0))) * wv;
        s1 += (c1 / (1.f + __expf(-c1))) * wv;
        s2 += (c2 / (1.f + __expf(-c2))) * wv;
    }
    float* red = (float*)smem;
    red[(kq * 3 + 0) * 64 + nn] = s0; red[(kq * 3 + 1) * 64 + nn] = s1; red[(kq * 3 + 2) * 64 + nn] = s2;
    __syncthreads();
    if (tid < 192) {
        const int r = tid >> 6;
        const float v = red[(0 * 3 + r) * 64 + nn] + red[(1 * 3 + r) * 64 + nn] + red[(2 * 3 + r) * 64 + nn] + red[(3 * 3 + r) * 64 + nn] + p.b_mod[l * 6144 + n];
        ((float*)(p.ws + OFF_mod))[(size_t)(l * 3 + r) * 6144 + n] = v;
    }
    __syncthreads();
}

DI void prologue_misc(const Ctx& cx, const Params& p, int u) {
    const int tid = cx.tid;
    if (u < 768) {
        const f32x4* a = (const f32x4*)p.x_prompt; const f32x4* b = (const f32x4*)p.x_sample; f32x4* o = (f32x4*)p.out;
#pragma unroll
        for (int j = 0; j < 8; ++j) { const int idx = u * 2048 + tid + 256 * j; o[idx] = idx < 1048576 ? a[idx] : b[idx - 1048576]; }
        return;
    }
    u -= 768;
    if (u < 512) {
        const int e = (u * 256 + tid) * 8;
        const int which = e >> 19, rem = e & ((1 << 19) - 1);
        const int b = rem >> 18, l = (rem >> 16) & 3, s = (rem >> 7) & 511, c = rem & 127;
        const float* src = (which ? p.ck_w : p.ck_a) + rem;
        const f32x4 v0 = *(const f32x4*)src, v1 = *(const f32x4*)(src + 4);
        bf16_t* dst = (which ? ((bf16_t*)(p.ws + OFF_kCl)) : ((bf16_t*)(p.ws + OFF_kAl))) + ((size_t)((l * 2 + b) * 1536 + s)) * 128 + c;
        *(u32x4*)dst = (u32x4){pack2(v0[0], v0[1]), pack2(v0[2], v0[3]), pack2(v1[0], v1[1]), pack2(v1[2], v1[3])};
        return;
    }
    u -= 512;
    if (u < 64) {
        const int which = u >> 5, l = (u >> 3) & 3, b = (u >> 2) & 1, sp = u & 3;
        const int col = tid & 127, s0 = (sp * 2 + (tid >> 7)) * 64;
        const float* src = (which ? p.cv_w : p.cv_a) + ((size_t)((b * 4 + l) * 512 + s0)) * 128 + col;
        bf16_t* dst = (which ? ((bf16_t*)(p.ws + OFF_vClT)) : ((bf16_t*)(p.ws + OFF_vAlT))) + ((size_t)((l * 2 + b) * 128 + col)) * 1536 + s0;
#pragma unroll
        for (int jc = 0; jc < 8; ++jc) {
            float v[8];
#pragma unroll
            for (int j = 0; j < 8; ++j) v[j] = src[(size_t)(jc * 8 + j) * 128];
            *(u32x4*)(dst + jc * 8) = (u32x4){pack2(v[0], v[1]), pack2(v[2], v[3]), pack2(v[4], v[5]), pack2(v[6], v[7])};
        }
        return;
    }
    u -= 64;
    {
#pragma unroll
        for (int j = 0; j < 4; ++j) {
            const int idx = tid + 256 * j; const int pos = idx >> 4, i = idx & 15;
            const float inv = 1.0f / powf(10000.0f, (float)i / 16.0f);
            const float ang = (float)pos * inv;
            ((float*)(p.ws + OFF_rope))[idx] = cosf(ang); ((float*)(p.ws + OFF_rope))[1024 + idx] = sinf(ang);
        }
    }
}
constexpr int PRO_T = 4816 * NL, PRO_MOD = 96 * NL, PRO_MISC = 768 + 512 + 64 + 1;

DI void norm_row(const Ctx& cx, const Params& p, int layer, int r, int which  ) {
    const int lane = cx.tid & 63;
    const f32x4* x = (const f32x4*)(p.out + (size_t)r * DM);
    f32x4 v[4]; float ss = 0.f;
#pragma unroll
    for (int i = 0; i < 4; ++i) { v[i] = x[lane + 64 * i]; ss += v[i][0] * v[i][0] + v[i][1] * v[i][1] + v[i][2] * v[i][2] + v[i][3] * v[i][3]; }
    ss = wave_sum(ss);
    const float rstd = rsqrtf(ss * (1.0f / DM) + 1e-6f);
    const float* g = (which ? p.g_ffn : p.g_mix) + layer * DM;
    const float* md = ((float*)(p.ws + OFF_mod)) + (size_t)(layer * 3 + condrow(r)) * 6144 + which * 3072;
#pragma unroll
    for (int i = 0; i < 4; ++i) {
        const int c = (lane + 64 * i) * 4;
        const f32x4 gv = *(const f32x4*)(g + c), sh = *(const f32x4*)(md + c), sc = *(const f32x4*)(md + DM + c);
        float o[4];
#pragma unroll
        for (int j = 0; j < 4; ++j) o[j] = v[i][j] * rstd * gv[j] * (1.f + sc[j]) + sh[j];
        *(u32x2*)(((bf16_t*)(p.ws + OFF_h)) + (size_t)r * DM + c) = (u32x2){pack2(o[0], o[1]), pack2(o[2], o[3])};
    }
}

constexpr int LSTR = 72;
constexpr int TILE_E = 128 * LSTR;
enum { E_IN = 0, E_BR = 1, E_RES = 2, E_GU = 3, E_POOL = 4 };
struct GemmArgs { const bf16_t* A; int lda; const bf16_t* Bt; int ldb; int K; int row0, col0; int layer; int aux; };

template <int EPI> DI void gemm_tile(const Ctx& cx, const Params& p, const GemmArgs& g, unsigned char* smem) {
    const int tid = cx.tid, wid = tid >> 6, lane = tid & 63, l31 = lane & 31, hh = lane >> 5, wm = wid >> 1, wn = wid & 1;
    bf16_t* As = (bf16_t*)smem;
    bf16_t* Bs = As + 2 * TILE_E;
    f32x16 acc[2][2], tot[2][2];
#pragma unroll
    for (int a = 0; a < 2; ++a)
#pragma unroll
        for (int b = 0; b < 2; ++b)
#pragma unroll
            for (int r = 0; r < 16; ++r) { acc[a][b][r] = 0.f; tot[a][b][r] = 0.f; }
    const int nk = g.K >> 6;
    const int lr = tid >> 3, lc = (tid & 7) * 8;
    const bf16_t* Ag = g.A + (size_t)(g.row0 + lr) * g.lda + lc;
    const bf16_t* Bg = g.Bt + (size_t)(g.col0 + lr) * g.ldb + lc;
    u32x4 ra[4], rb[4];
#pragma unroll
    for (int i = 0; i < 4; ++i) { ra[i] = *(const u32x4*)(Ag + (size_t)(32 * i) * g.lda); rb[i] = *(const u32x4*)(Bg + (size_t)(32 * i) * g.ldb); }
#pragma unroll
    for (int i = 0; i < 4; ++i) { *(u32x4*)(As + (lr + 32 * i) * LSTR + lc) = ra[i]; *(u32x4*)(Bs + (lr + 32 * i) * LSTR + lc) = rb[i]; }
    __syncthreads();
    for (int kt = 0; kt < nk; ++kt) {
        const int buf = kt & 1;
        if (kt + 1 < nk) {
#pragma unroll
            for (int i = 0; i < 4; ++i) { ra[i] = *(const u32x4*)(Ag + (size_t)(32 * i) * g.lda + (kt + 1) * 64); rb[i] = *(const u32x4*)(Bg + (size_t)(32 * i) * g.ldb + (kt + 1) * 64); }
        }
        const bf16_t* ab = As + buf * TILE_E + (wm * 64 + l31) * LSTR + hh * 8;
        const bf16_t* bb = Bs + buf * TILE_E + (wn * 64 + l31) * LSTR + hh * 8;
#pragma unroll
        for (int ks = 0; ks < 4; ++ks) {
            const bf16x8 a0 = *(const bf16x8*)(ab + ks * 16), a1 = *(const bf16x8*)(ab + 32 * LSTR + ks * 16);
            const bf16x8 b0 = *(const bf16x8*)(bb + ks * 16), b1 = *(const bf16x8*)(bb + 32 * LSTR + ks * 16);
            acc[0][0] = __builtin_amdgcn_mfma_f32_32x32x16_bf16(a0, b0, acc[0][0], 0, 0, 0);
            acc[0][1] = __builtin_amdgcn_mfma_f32_32x32x16_bf16(a0, b1, acc[0][1], 0, 0, 0);
            acc[1][0] = __builtin_amdgcn_mfma_f32_32x32x16_bf16(a1, b0, acc[1][0], 0, 0, 0);
            acc[1][1] = __builtin_amdgcn_mfma_f32_32x32x16_bf16(a1, b1, acc[1][1], 0, 0, 0);
        }
        if (EPI == E_BR && (kt & 7) == 7) {
            const int kbr = kt >> 3;
            const bf16_t* gp = ((bf16_t*)(p.ws + OFF_gates)) + ((size_t)((((g.row0 >> 7) * 4 + kbr) * 8 + (g.col0 >> 7)) * 256 + tid)) * 64;
#pragma unroll
            for (int mi = 0; mi < 2; ++mi) {
                u32x4 gw[4];
#pragma unroll
                for (int q = 0; q < 4; ++q) gw[q] = *(const u32x4*)(gp + mi * 32 + q * 8);
#pragma unroll
                for (int ni = 0; ni < 2; ++ni)
#pragma unroll
                    for (int r = 0; r < 16; ++r) {
                        const unsigned w = gw[ni * 2 + (r >> 3)][(r & 7) >> 1];
                        const float gv = (r & 1) ? __uint_as_float(w & 0xffff0000u) : __uint_as_float(w << 16);
                        tot[mi][ni][r] += gv * acc[mi][ni][r]; acc[mi][ni][r] = 0.f;
                    }
            }
        }
        if (kt + 1 < nk) {
            const int nb = buf ^ 1;
#pragma unroll
            for (int i = 0; i < 4; ++i) { *(u32x4*)(As + nb * TILE_E + (lr + 32 * i) * LSTR + lc) = ra[i]; *(u32x4*)(Bs + nb * TILE_E + (lr + 32 * i) * LSTR + lc) = rb[i]; }
        }
        __syncthreads();
    }
    if (EPI == E_IN && g.col0 >= NPR) {
        const int gc = g.col0 - NPR;
        bf16_t* gp = ((bf16_t*)(p.ws + OFF_gates)) + ((size_t)((((g.row0 >> 7) * 4 + (gc >> 10)) * 8 + ((gc & 1023) >> 7)) * 256 + tid)) * 64;
#pragma unroll
        for (int mi = 0; mi < 2; ++mi)
#pragma unroll
            for (int ni = 0; ni < 2; ++ni)
#pragma unroll
                for (int q = 0; q < 2; ++q) {
                    unsigned w[4];
#pragma unroll
                    for (int j = 0; j < 4; ++j) {
                        const float a = acc[mi][ni][q * 8 + 2 * j], b = acc[mi][ni][q * 8 + 2 * j + 1];
                        w[j] = pack2(1.f / (1.f + __expf(-a)), 1.f / (1.f + __expf(-b)));
                    }
                    *(u32x4*)(gp + (mi * 2 + ni) * 16 + q * 8) = (u32x4){w[0], w[1], w[2], w[3]};
                }
        return;
    }
#pragma unroll
    for (int mi = 0; mi < 2; ++mi)
#pragma unroll
        for (int r = 0; r < 16; ++r) {
            const int row = g.row0 + wm * 64 + mi * 32 + (r & 3) + 8 * (r >> 2) + 4 * hh;
            if (EPI == E_GU) {
                const float a = acc[mi][0][r], b = acc[mi][1][r];
                const int ac = ((g.col0 + wn * 64) >> 1) + l31;
                ((bf16_t*)(p.ws + OFF_act))[(size_t)row * DFF + ac] = f2bf(a / (1.f + __expf(-a)) * b);
            } else {
#pragma unroll
                for (int ni = 0; ni < 2; ++ni) {
                    const int col = g.col0 + wn * 64 + ni * 32 + l31;
                    const float v = acc[mi][ni][r];
                    if (EPI == E_IN) {
                        ((float*)(p.ws + OFF_P))[(size_t)row * NPR + col] = v;
                    } else if (EPI == E_BR) {
                        ((bf16_t*)(p.ws + OFF_merged))[(size_t)row * DM + col] = f2bf(tot[mi][ni][r]);
                    } else if (EPI == E_RES) {
                        const float gm = ((float*)(p.ws + OFF_mod))[(size_t)(g.layer * 3 + condrow(row)) * 6144 + g.aux * DM + col];
                        float* o = p.out + (size_t)row * DM + col;
                        *o = *o + gm * v;
                    } else if (EPI == E_POOL) {
                        ((bf16_t*)(p.ws + OFF_br))[(size_t)row * 2048 + 1536 + g.aux * 128 + col] = f2bf(v * p.pool_scale[g.layer * 512 + g.aux * 128 + col]);
                    }
                }
            }
        }
}

template <int EPI> DI void gemm_phase(const Ctx& cx, const Params& p, int layer, const bf16_t* A, int lda, const bf16_t* Bt, int ldb, int K, int N, int aux, unsigned char* smem) {
    const int nM = NTOK / 128, nN = N / 128;
    const int ntp = ((nN + 7) / 8) * 8 * nM;
    for (int t = cx.bid; t < ntp; t += gridDim.x) {
        const int lo = t & 7, rest = t >> 3; const int pm = rest % nM, pn = (rest / nM) * 8 + lo;
        if (pn >= nN) continue;
        GemmArgs g; g.A = A; g.lda = lda; g.Bt = Bt; g.ldb = ldb; g.K = K; g.row0 = pm * 128; g.col0 = pn * 128; g.layer = layer; g.aux = aux;
        gemm_tile<EPI>(cx, p, g, smem);
    }
}

DI void post_vunit(const Ctx& cx, const Params& p, int layer, int vt) {
    const int tid = cx.tid; const int which = tid >> 7, col = tid & 127;
    const int r0 = vt * 64;
    const float* src = ((float*)(p.ws + OFF_P)) + (size_t)r0 * NPR + (which ? 1408 : 640) + col;
    bf16_t* dst; float* of = nullptr;
    if (r0 < NCTX) { const int b = r0 >> 8, t0 = r0 & 255;
        dst = (which ? ((bf16_t*)(p.ws + OFF_vCcT)) : ((bf16_t*)(p.ws + OFF_vAcT))) + ((size_t)(b * 128 + col)) * 256 + t0;
        of = p.out + (which ? OUT_VW : OUT_VA) + ((size_t)((b * 4 + layer) * 256 + t0)) * 128 + col;
    } else { const int b = (r0 - NCTX) >> 10, t0 = (r0 - NCTX) & 1023;
        dst = (which ? ((bf16_t*)(p.ws + OFF_vClT)) : ((bf16_t*)(p.ws + OFF_vAlT))) + ((size_t)((layer * 2 + b) * 128 + col)) * 1536 + 512 + t0;
    }
#pragma unroll
    for (int jc = 0; jc < 8; ++jc) {
        float v[8];
#pragma unroll
        for (int j = 0; j < 8; ++j) v[j] = src[(size_t)(jc * 8 + j) * NPR];
        if (of) {
#pragma unroll
            for (int j = 0; j < 8; ++j) of[(size_t)(jc * 8 + j) * 128] = v[j];
        }
        *(u32x4*)(dst + jc * 8) = (u32x4){pack2(v[0], v[1]), pack2(v[2], v[3]), pack2(v[4], v[5]), pack2(v[6], v[7])};
    }
}

DI void post_row(const Ctx& cx, const Params& p, int layer, int r) {
    const int lane = cx.tid & 63;
    const float* Pr = ((float*)(p.ws + OFF_P)) + (size_t)r * NPR;
    const bool lat = r >= NCTX;
    int b, t, T;
    if (lat) { b = (r - NCTX) >> 10; t = (r - NCTX) & 1023; T = 1024; } else { b = r >> 8; t = r & 255; T = 256; }
    float cs = 1.f, sn = 0.f;
    if (lat) { const int pos = (lane < 32) ? (t >> 6) : (t & 63); const int i = lane & 15; cs = ((float*)(p.ws + OFF_rope))[pos * 16 + i]; sn = ((float*)(p.ws + OFF_rope))[1024 + pos * 16 + i]; if (!(lane & 16)) sn = -sn; }
#pragma unroll 1
    for (int hd = 0; hd < 20; ++hd) {
        int col; const float* gp; bool isk = false; int which = 0, hk = 0;
        if (hd < 8) { col = hd * 64; gp = p.gq_a; }
        else if (hd < 10) { col = 512 + (hd - 8) * 64; gp = p.gk_a; isk = true; hk = hd - 8; }
        else if (hd < 18) { col = 768 + (hd - 10) * 64; gp = p.gq_c; which = 1; }
        else { col = 1280 + (hd - 18) * 64; gp = p.gk_c; isk = true; which = 1; hk = hd - 18; }
        const float v = Pr[col + lane];
        const float ss = wave_sum(v * v);
        float y = v * rsqrtf(ss * (1.0f / 64.f) + 1e-6f) * gp[layer * 64 + lane];
        if (lat) { const float pr = __shfl_xor(y, 16); y = y * cs + pr * sn; }
        if (!isk) {
            const int qh = which ? hd - 10 : hd;
            (which ? ((bf16_t*)(p.ws + OFF_qC)) : ((bf16_t*)(p.ws + OFF_qA)))[(size_t)r * 512 + qh * 64 + lane] = f2bf(y * QSCALE);
        } else if (!lat) {
            (which ? ((bf16_t*)(p.ws + OFF_kCc)) : ((bf16_t*)(p.ws + OFF_kAc)))[(size_t)r * 128 + hk * 64 + lane] = f2bf(y);
            p.out[(which ? OUT_KW : OUT_KA) + ((size_t)((b * 4 + layer) * 256 + t)) * 128 + hk * 64 + lane] = y;
        } else {
            (which ? ((bf16_t*)(p.ws + OFF_kCl)) : ((bf16_t*)(p.ws + OFF_kAl)))[((size_t)((layer * 2 + b) * 1536 + 512 + t)) * 128 + hk * 64 + lane] = f2bf(y);
        }
    }
    const float* cw = p.conv_w + layer * 3 * 512;
#pragma unroll 1
    for (int i = 0; i < 8; ++i) {
        const int c = lane + 64 * i;
        const float z0 = Pr[2560 + c] * Pr[1536 + c];
        const float zm = (t > 0) ? Pr[-NPR + 2560 + c] * Pr[-NPR + 1536 + c] : 0.f;
        const float zp = (t < T - 1) ? Pr[NPR + 2560 + c] * Pr[NPR + 1536 + c] : 0.f;
        const float y = Pr[2048 + c] * (zm * cw[c] + z0 * cw[512 + c] + zp * cw[1024 + c]);
        ((bf16_t*)(p.ws + OFF_br))[(size_t)r * 2048 + 512 + c] = f2bf(y);
        const int w = 2 << (i >> 1);
        int lo = t - (w >> 1); lo = lo < 0 ? 0 : lo;
        int hi = t + (w >> 1); hi = hi > T ? T : hi;
        float s = 0.f;
        for (int q = lo; q < hi; ++q) s += Pr[(ptrdiff_t)(q - t) * NPR + 3072 + c];
        const float ym = s / (float)(hi - lo) - Pr[3072 + c];
        ((bf16_t*)(p.ws + OFF_ypool))[(size_t)r * 512 + c] = f2bf(ym);
    }
}

constexpr int KSTR = 72, VSTR = 68;
constexpr int ATT_BUF_E = 64 * KSTR + 64 * VSTR;
DI void attn_unit(const Ctx& cx, const Params& p, int layer, int kind, int b, int head, int qb, unsigned char* smem) {
    const int tid = cx.tid, wid = tid >> 6, lane = tid & 63, ql = lane & 31, hh = lane >> 5;
    const bool isC = kind & 1, isLat = kind >= 2;
    const int kvh = head >> 2;
    const int qrow = (isLat ? NCTX + b * 1024 : b * 256) + qb * 128 + wid * 32 + ql;
    const bf16_t* Kp; const bf16_t* Vt; int S;
    if (!isLat) { S = 256; Kp = (isC ? ((bf16_t*)(p.ws + OFF_kCc)) : ((bf16_t*)(p.ws + OFF_kAc))) + (size_t)b * 256 * 128 + kvh * 64; Vt = (isC ? ((bf16_t*)(p.ws + OFF_vCcT)) : ((bf16_t*)(p.ws + OFF_vAcT))) + (size_t)((b * 2 + kvh) * 64) * 256; }
    else { S = 1536; Kp = (isC ? ((bf16_t*)(p.ws + OFF_kCl)) : ((bf16_t*)(p.ws + OFF_kAl))) + (size_t)((layer * 2 + b) * 1536) * 128 + kvh * 64; Vt = (isC ? ((bf16_t*)(p.ws + OFF_vClT)) : ((bf16_t*)(p.ws + OFF_vAlT))) + (size_t)(((layer * 2 + b) * 2 + kvh) * 64) * 1536; }
    int nt1 = S / 64, t2lo = 0, t2hi = 0;
    if (kind == 3) { nt1 = 8; const int i0 = qb * 128; const int jlo = i0 - 128 < 0 ? 0 : i0 - 128; const int jhi = i0 + 256 > 1024 ? 1024 : i0 + 256; t2lo = 8 + (jlo >> 6); t2hi = 8 + (jhi >> 6); }
    const int ntiles = nt1 + (t2hi - t2lo);
    bf16x8 qf[4];
    { const bf16_t* q = (isC ? ((bf16_t*)(p.ws + OFF_qC)) : ((bf16_t*)(p.ws + OFF_qA))) + (size_t)qrow * 512 + head * 64 + hh * 8;
#pragma unroll
      for (int ks = 0; ks < 4; ++ks) qf[ks] = *(const bf16x8*)(q + ks * 16); }
    bf16_t* L = (bf16_t*)smem;
    const int sr = tid >> 3, scc = (tid & 7) * 8;
    u32x4 rk[2], rv[2];
    auto gload = [&](int it) {
        const int kt = it < nt1 ? it : t2lo + (it - nt1);
#pragma unroll
        for (int i = 0; i < 2; ++i) {
            rk[i] = *(const u32x4*)(Kp + (size_t)(kt * 64 + sr + 32 * i) * 128 + scc);
            rv[i] = *(const u32x4*)(Vt + (size_t)(sr + 32 * i) * S + kt * 64 + scc);
        }
    };
    auto lstore = [&](int buf) {
        bf16_t* Ks = L + buf * ATT_BUF_E; bf16_t* Vs = Ks + 64 * KSTR;
#pragma unroll
        for (int i = 0; i < 2; ++i) {
            *(u32x4*)(Ks + (sr + 32 * i) * KSTR + scc) = rk[i];
            u32x2* vd = (u32x2*)(Vs + (sr + 32 * i) * VSTR + scc);
            vd[0] = (u32x2){rv[i][0], rv[i][1]}; vd[1] = (u32x2){rv[i][2], rv[i][3]};
        }
    };
    f32x16 ot[2];
#pragma unroll
    for (int r = 0; r < 16; ++r) { ot[0][r] = 0.f; ot[1][r] = 0.f; }
    float m = -1e30f, lsum = 0.f;
    const int qpos = qb * 128 + wid * 32 + ql;
    gload(0); lstore(0); __syncthreads();
    for (int it = 0; it < ntiles; ++it) {
        const int buf = it & 1;
        if (it + 1 < ntiles) gload(it + 1);
        const bf16_t* Ks = L + buf * ATT_BUF_E; const bf16_t* Vs = Ks + 64 * KSTR;
        f32x16 st[2];
#pragma unroll
        for (int j = 0; j < 2; ++j) {
#pragma unroll
            for (int r = 0; r < 16; ++r) st[j][r] = 0.f;
#pragma unroll
            for (int ks = 0; ks < 4; ++ks) {
                const bf16x8 a = *(const bf16x8*)(Ks + (j * 32 + ql) * KSTR + ks * 16 + hh * 8);
                st[j] = __builtin_amdgcn_mfma_f32_32x32x16_bf16(a, qf[ks], st[j], 0, 0, 0);
            }
        }
        if (kind == 3 && it >= nt1) {
            const int kt = t2lo + (it - nt1);
            const int jbase = kt * 64 - 512;
#pragma unroll
            for (int j = 0; j < 2; ++j)
#pragma unroll
                for (int r = 0; r < 16; ++r) {
                    const int jp = jbase + j * 32 + (r & 3) + 8 * (r >> 2) + 4 * hh;
                    const int d = qpos - jp;
                    if (d > 128 || d < -128) st[j][r] = -1e30f;
                }
        }
        float mx = st[0][0];
#pragma unroll
        for (int j = 0; j < 2; ++j)
#pragma unroll
            for (int r = 0; r < 16; ++r) mx = fmaxf(mx, st[j][r]);
        mx = fmaxf(mx, __shfl_xor(mx, 32));
        const float mn = fmaxf(m, mx);
        const float alpha = __builtin_amdgcn_exp2f(m - mn);
        m = mn;
        float ps = 0.f;
#pragma unroll
        for (int j = 0; j < 2; ++j)
#pragma unroll
            for (int r = 0; r < 16; ++r) { const float e = __builtin_amdgcn_exp2f(st[j][r] - mn); st[j][r] = e; ps += e; }
        lsum = lsum * alpha + ps;
#pragma unroll
        for (int r = 0; r < 16; ++r) { ot[0][r] *= alpha; ot[1][r] *= alpha; }
#pragma unroll
        for (int j = 0; j < 2; ++j)
#pragma unroll
            for (int s2 = 0; s2 < 2; ++s2) {
                const u32x4 pw = (u32x4){pack2(st[j][8 * s2 + 0], st[j][8 * s2 + 1]), pack2(st[j][8 * s2 + 2], st[j][8 * s2 + 3]),
                                         pack2(st[j][8 * s2 + 4], st[j][8 * s2 + 5]), pack2(st[j][8 * s2 + 6], st[j][8 * s2 + 7])};
                const bf16x8 pf = __builtin_bit_cast(bf16x8, pw);
#pragma unroll
                for (int db = 0; db < 2; ++db) {
                    const bf16_t* vp = Vs + (db * 32 + ql) * VSTR + j * 32 + s2 * 16 + 4 * hh;
                    const s16x4 lo = *(const s16x4*)vp, hi = *(const s16x4*)(vp + 8);
                    const bf16x8 vf = __builtin_shufflevector(lo, hi, 0, 1, 2, 3, 4, 5, 6, 7);
                    ot[db] = __builtin_amdgcn_mfma_f32_32x32x16_bf16(vf, pf, ot[db], 0, 0, 0);
                }
            }
        if (it + 1 < ntiles) lstore(buf ^ 1);
        __syncthreads();
    }
    float lt = lsum + __shfl_xor(lsum, 32);
    float oscale = 1.f;
    if (isC) {
        const float sk = p.sink[layer * 8 + head] * LOG2E;
        const float mf = fmaxf(m, sk);
        oscale = __builtin_amdgcn_exp2f(m - mf);
        lt = lt * oscale + __builtin_amdgcn_exp2f(sk - mf);
    }
    const float inv = oscale / lt;
    bf16_t* o = ((bf16_t*)(p.ws + OFF_br)) + (size_t)qrow * 2048 + (isC ? 1024 : 0) + head * 64;
#pragma unroll
    for (int db = 0; db < 2; ++db)
#pragma unroll
        for (int g4 = 0; g4 < 4; ++g4) {
            const int d = db * 32 + 8 * g4 + 4 * hh;
            *(u32x2*)(o + d) = (u32x2){pack2(ot[db][4 * g4 + 0] * inv, ot[db][4 * g4 + 1] * inv), pack2(ot[db][4 * g4 + 2] * inv, ot[db][4 * g4 + 3] * inv)};
        }
}

DI void run_phase(const Ctx& cx, const Params& p, int ph, unsigned char* smem) {
    const int tid = cx.tid, wid = tid >> 6;
    if (ph == 0) {
        const int total = PRO_MOD + PRO_T + PRO_MISC;
        for (int u = cx.bid; u < total; u += gridDim.x) {
            if (u < PRO_MOD) prologue_mod(cx, p, u, smem);
            else if (u < PRO_MOD + PRO_T) prologue_transpose(cx, p, u - PRO_MOD, smem);
            else prologue_misc(cx, p, u - PRO_MOD - PRO_T);
        }
        return;
    }
    const int layer = (ph - 1) / 9, sub = (ph - 1) % 9;
    switch (sub) {
    case 0: for (int r = cx.bid * 4 + wid; r < NTOK; r += gridDim.x * 4) norm_row(cx, p, layer, r, 0); break;
    case 1: gemm_phase<E_IN>(cx, p, layer, ((bf16_t*)(p.ws + OFF_h)), DM, ((bf16_t*)(p.ws + OFF_WinT)) + (size_t)layer * NIN * DM, DM, DM, NIN, 0, smem); break;
    case 2: for (int u = cx.bid; u < 96 + 1536; u += gridDim.x) { if (u < 96) post_vunit(cx, p, layer, u); else post_row(cx, p, layer, (u - 96) * 4 + wid); } break;
    case 3:
        for (int u = cx.bid; u < 960; u += gridDim.x) {
            if (u < 128) attn_unit(cx, p, layer, 2, u >> 6, (u >> 3) & 7, u & 7, smem);
            else if (u < 256) { const int v = u - 128; attn_unit(cx, p, layer, 3, v >> 6, (v >> 3) & 7, v & 7, smem); }
            else if (u < 512) { const int v = u - 256; attn_unit(cx, p, layer, 0, v >> 4, (v >> 1) & 7, v & 1, smem); }
            else if (u < 768) { const int v = u - 512; attn_unit(cx, p, layer, 1, v >> 4, (v >> 1) & 7, v & 1, smem); }
            else { const int v = u - 768; const int pm = v >> 2, grp = v & 3;
                GemmArgs g; g.A = ((bf16_t*)(p.ws + OFF_ypool)) + grp * 128; g.lda = 512; g.Bt = ((bf16_t*)(p.ws + OFF_PoolT)) + (size_t)(layer * 4 + grp) * 16384; g.ldb = 128; g.K = 128; g.row0 = pm * 128; g.col0 = 0; g.layer = layer; g.aux = grp;
                gemm_tile<E_POOL>(cx, p, g, smem); }
        }
        break;
    case 4: gemm_phase<E_BR>(cx, p, layer, ((bf16_t*)(p.ws + OFF_br)), 2048, ((bf16_t*)(p.ws + OFF_WbrT)) + (size_t)layer * DM * 2048, 2048, 2048, DM, 0, smem); break;
    case 5: gemm_phase<E_RES>(cx, p, layer, ((bf16_t*)(p.ws + OFF_merged)), DM, ((bf16_t*)(p.ws + OFF_WoT)) + (size_t)layer * DM * DM, DM, DM, DM, 2, smem); break;
    case 6: for (int r = cx.bid * 4 + wid; r < NTOK; r += gridDim.x * 4) norm_row(cx, p, layer, r, 1); break;
    case 7: gemm_phase<E_GU>(cx, p, layer, ((bf16_t*)(p.ws + OFF_h)), DM, ((bf16_t*)(p.ws + OFF_WguT)) + (size_t)layer * 2 * DFF * DM, DM, DM, 2 * DFF, 0, smem); break;
    case 8: gemm_phase<E_RES>(cx, p, layer, ((bf16_t*)(p.ws + OFF_act)), DFF, ((bf16_t*)(p.ws + OFF_WdT)) + (size_t)layer * DM * DFF, DFF, DFF, DM, 5, smem); break;
    }
}

__global__ void __launch_bounds__(256, 2) fwd_megakernel(Params p) {
    __shared__ __attribute__((aligned(16))) unsigned char smem[73728];
    __shared__ uint4 xbw;
#if MK_MULTI
    Ctx cx; cx.tid = threadIdx.x; cx.bid = blockIdx.x;
    run_phase(cx, p, p.phase_lo, smem);
#else
    if (threadIdx.x == 0) xbw = make_uint4(0u, 0u, 0u, 0u);
    __syncthreads();
    XcdBarrier xb = xcd_barrier_post((unsigned*)(p.ws + OFF_bar), (volatile LAS unsigned*)&xbw);
    if (p.phase_lo < 0) cg::this_grid().sync();
    for (int ph = p.phase_lo; ph < p.phase_hi; ++ph) {
        Ctx cx; cx.tid = threadIdx.x; cx.bid = blockIdx.x;
        asm volatile("" : "+v"(cx.tid));
        asm volatile("" : "+s"(cx.bid));
        Params q = p;
        asm volatile("" : "+s"(q.ws));
        asm volatile("" : "+s"(q.out));
        run_phase(cx, q, ph, smem);
        if (ph + 1 < p.phase_hi) xcd_barrier(xb);
    }
#endif
}

extern "C" void kernel_launch(void* const* d_in, const int* in_sizes, int n_in, void* d_out, int out_size, void* d_ws, size_t ws_size, hipStream_t stream) {
    Params p; memset(&p, 0, sizeof(p));
    const float* const* in = (const float* const*)d_in;
    p.x_prompt = in[0]; p.x_sample = in[1]; p.ck_a = in[2]; p.cv_a = in[3]; p.ck_w = in[4]; p.cv_w = in[5]; p.c = in[6]; p.c_ctx = in[7];
    p.w_mod = in[8]; p.b_mod = in[9]; p.g_mix = in[10]; p.g_ffn = in[11]; p.w_in = in[12]; p.gq_a = in[13]; p.gk_a = in[14]; p.gq_c = in[15]; p.gk_c = in[16];
    p.sink = in[17]; p.conv_w = in[18]; p.pool_w = in[19]; p.pool_scale = in[20]; p.w_br = in[21]; p.w_o = in[22]; p.w_gu = in[23]; p.w_down = in[24];
    p.out = (float*)d_out;
    p.ws = (unsigned char*)d_ws;
    if (WS_TOTAL > ws_size) { fprintf(stderr, "workspace too small: need %zu have %zu\n", (size_t)WS_TOTAL, ws_size); return; }
#if MK_MULTI
    for (int ph = 0; ph < NPHASE; ++ph) {
        p.phase_lo = ph; p.phase_hi = ph + 1;
        hipLaunchKernelGGL(fwd_megakernel, dim3(512), dim3(256), 0, stream, p);
    }
#else
    static int grid_blocks = 0;
    if (!grid_blocks) {
        int dev = 0, cus = 0, per_cu = 0;
        hipGetDevice(&dev);
        hipDeviceGetAttribute(&cus, hipDeviceAttributeMultiprocessorCount, dev);
        hipOccupancyMaxActiveBlocksPerMultiprocessor(&per_cu, fwd_megakernel, 256, 0);
        if (per_cu > 2) per_cu = 2;
        if (per_cu < 1) per_cu = 1;
        grid_blocks = cus * per_cu;
    }
    p.phase_lo = 0; p.phase_hi = NPHASE;
    (void)hipMemsetAsync(p.ws + OFF_bar, 0, 16384, stream);
    void* args[] = {&p};
    hipError_t e = hipLaunchCooperativeKernel((void*)fwd_megakernel, dim3(grid_blocks), dim3(256), args, 0, stream);
    if (e != hipSuccess) fprintf(stderr, "cooperative launch failed: %s (grid %d)\n", hipGetErrorString(e), grid_blocks);
#endif
}
```

```cpp
#include <hip/hip_runtime.h>
#include <hip/hip_cooperative_groups.h>
#include <cstdio>
#include <cstdint>
#include <cstring>
namespace cg = cooperative_groups;

#ifndef PROBE2
#define PROBE2 0
#endif
#ifndef PROBE_REP
#define PROBE_REP 0
#endif
#ifndef PROBE_DRYBITS
#define PROBE_DRYBITS 8
#endif
#ifndef MK_MULTI
#define MK_MULTI 0
#endif

typedef unsigned short bf16_t;
typedef short bf16x8 __attribute__((ext_vector_type(8)));
typedef short s16x4 __attribute__((ext_vector_type(4)));
typedef float f32x16 __attribute__((ext_vector_type(16)));
typedef float f32x4 __attribute__((ext_vector_type(4)));
typedef unsigned u32x4 __attribute__((ext_vector_type(4)));
typedef unsigned u32x2 __attribute__((ext_vector_type(2)));
#define DI __device__ __forceinline__
#define LAS __attribute__((address_space(3)))

constexpr int NTOK = 6144, NCTX = 4096, DM = 1024, NIN = 7680, NPR = 3584, DFF = 2816, NL = 4;
constexpr float LOG2E = 1.4426950408889634f;
constexpr float QSCALE = 0.125f * LOG2E;
constexpr size_t OUT_KA = 6291456, OUT_VA = 8388608, OUT_KW = 10485760, OUT_VW = 12582912;
constexpr int NPHASE = 2 + 7 * NL;
constexpr float SSQ_SCALE = 256.f, SSQ_INV = 1.0f / 256.f, BIAS_SCALE = 16777216.f, BIAS_INV = 1.0f / 16777216.f;
constexpr int NBIAS = NIN + 2 * DFF;

constexpr size_t al256(size_t x) { return (x + 255) & ~(size_t)255; }
constexpr size_t OFF_bar = 0;
constexpr size_t OFF_mod = OFF_bar + al256(16384);
constexpr size_t OFF_rope = OFF_mod + al256((size_t)NL * 3 * 6144 * 4);
constexpr size_t OFF_WinT = OFF_rope + al256(2048 * 4);
constexpr size_t OFF_WbrT = OFF_WinT + al256((size_t)NL * NIN * DM * 2);
constexpr size_t OFF_WoT = OFF_WbrT + al256((size_t)NL * DM * 2048 * 2);
constexpr size_t OFF_WguT = OFF_WoT + al256((size_t)NL * DM * DM * 2);
constexpr size_t OFF_WdT = OFF_WguT + al256((size_t)NL * 2 * DFF * DM * 2);
constexpr size_t OFF_PoolT = OFF_WdT + al256((size_t)NL * DM * DFF * 2);
constexpr size_t OFF_h = OFF_PoolT + al256((size_t)NL * 4 * 128 * 128 * 2);
constexpr size_t OFF_P = OFF_h + al256((size_t)NTOK * DM * 2);
constexpr size_t OFF_gates = OFF_P + al256((size_t)NTOK * NPR * 4);
constexpr size_t OFF_qA = OFF_gates + al256((size_t)NTOK * 4096 * 2);
constexpr size_t OFF_qC = OFF_qA + al256((size_t)NTOK * 512 * 2);
constexpr size_t OFF_kAc = OFF_qC + al256((size_t)NTOK * 512 * 2);
constexpr size_t OFF_kCc = OFF_kAc + al256((size_t)NCTX * 128 * 2);
constexpr size_t OFF_kAl = OFF_kCc + al256((size_t)NCTX * 128 * 2);
constexpr size_t OFF_kCl = OFF_kAl + al256((size_t)NL * 2 * 1536 * 128 * 2);
constexpr size_t OFF_vAcT = OFF_kCl + al256((size_t)NL * 2 * 1536 * 128 * 2);
constexpr size_t OFF_vCcT = OFF_vAcT + al256((size_t)NCTX * 128 * 2);
constexpr size_t OFF_vAlT = OFF_vCcT + al256((size_t)NCTX * 128 * 2);
constexpr size_t OFF_vClT = OFF_vAlT + al256((size_t)NL * 2 * 1536 * 128 * 2);
constexpr size_t OFF_ypool = OFF_vClT + al256((size_t)NL * 2 * 1536 * 128 * 2);
constexpr size_t OFF_br = OFF_ypool + al256((size_t)NTOK * 512 * 2);
constexpr size_t OFF_merged = OFF_br + al256((size_t)NTOK * 2048 * 2);
constexpr size_t OFF_act = OFF_merged + al256((size_t)NTOK * DM * 2);
constexpr size_t OFF_ssq = OFF_act + al256((size_t)NTOK * DFF * 2);
constexpr size_t OFF_bias = OFF_ssq + al256((size_t)NL * 2 * NTOK * 4);
constexpr size_t WS_TOTAL = OFF_bias + al256((size_t)NL * 3 * NBIAS * 4);

struct Ctx { int tid, bid; };
struct Params {
    const float *x_prompt, *x_sample, *ck_a, *cv_a, *ck_w, *cv_w, *c, *c_ctx;
    const float *w_mod, *b_mod, *g_mix, *g_ffn, *w_in, *gq_a, *gk_a, *gq_c, *gk_c, *sink, *conv_w, *pool_w, *pool_scale, *w_br, *w_o, *w_gu, *w_down;
    __attribute__((address_space(1))) float* out;
    __attribute__((address_space(1))) unsigned char* ws;
    int phase_lo, phase_hi;
};

DI bf16_t f2bf(float x) { return __builtin_bit_cast(unsigned short, (__bf16)x); }
DI float bf2f(bf16_t v) { return __uint_as_float(((unsigned)v) << 16); }
DI unsigned pack2(float lo, float hi) {
    typedef __bf16 bf2 __attribute__((ext_vector_type(2)));
    typedef float f2 __attribute__((ext_vector_type(2)));
    f2 x = {lo, hi};
    return __builtin_bit_cast(unsigned, __builtin_convertvector(x, bf2));
}
DI size_t wtile_off(int n, int k, int K) { return ((size_t)(n >> 7) * (K >> 5) + (k >> 5)) * 4096 + (n & 127) * 32 + (k & 31); }
DI float wave_sum(float v) {
#pragma unroll
    for (int o = 32; o >= 1; o >>= 1) v += __shfl_xor(v, o);
    return v;
}
DI float fsigmoid(float x) { return __builtin_amdgcn_rcpf(1.f + __builtin_amdgcn_exp2f(-LOG2E * x)); }
DI void sigmoid16(const f32x16& x, float (&o)[16]) {
#pragma unroll
    for (int r = 0; r < 16; ++r) o[r] = x[r] * (-LOG2E);
    __builtin_amdgcn_sched_barrier(0);
#pragma unroll
    for (int r = 0; r < 16; ++r) o[r] = __builtin_amdgcn_exp2f(o[r]);
    __builtin_amdgcn_sched_barrier(0);
#pragma unroll
    for (int r = 0; r < 16; ++r) o[r] = 1.f + o[r];
#pragma unroll
    for (int r = 0; r < 16; ++r) o[r] = __builtin_amdgcn_rcpf(o[r]);
    __builtin_amdgcn_sched_barrier(0);
}
DI int condrow(int r) { return r < NCTX ? 0 : 1 + ((r - NCTX) >> 10); }

#define XB_TMO      128
#define XB_XCNT(j)  (256  + 64 * (j))
#define XB_XSUB(j)  (1280 + 64 * (j))
#define XB_XGEN(j)  (2304 + 64 * (j))
#define XB_TOP      3328
#define XB_TOPGEN   3392
#define XCD_BAR_WORDS 3456
#define XB_SPIN_CAP (1u << 22)
DI unsigned xb_ld(unsigned* p) { return __hip_atomic_load(p, __ATOMIC_RELAXED, __HIP_MEMORY_SCOPE_AGENT); }
DI unsigned xb_add(unsigned* p, unsigned v) { return __hip_atomic_fetch_add(p, v, __ATOMIC_RELAXED, __HIP_MEMORY_SCOPE_AGENT); }
DI unsigned xb_xcc_id() { return (unsigned)__builtin_amdgcn_s_getreg((3 << 11) | 20) & 0xFu; }
#define XB_SPIN(cond, bar) do { unsigned _sp = 0; while (cond) { __builtin_amdgcn_s_sleep(1); \
    if ((++_sp & 255u) == 0u) { if (xb_ld(&(bar)[XB_TMO])) break; if (_sp > XB_SPIN_CAP) { atomicAdd(&(bar)[XB_TMO], 1u); break; } } } } while (0)
struct XcdBarrier { unsigned* bar; unsigned x; volatile LAS unsigned* st; };
DI XcdBarrier xcd_barrier_post(unsigned* bar, volatile LAS unsigned* st) {
    XcdBarrier b; b.bar = bar; b.x = xb_xcc_id(); b.st = st;
    if (threadIdx.x == 0) (void)xb_add(&bar[XB_XCNT(b.x)], 1u);
    return b;
}
DI void xcd_barrier_complete(unsigned* bar, unsigned x, unsigned& nloc, unsigned& nx) {
    const unsigned G = gridDim.x * gridDim.y * gridDim.z;
    unsigned sum, cnt, mine, sp = 0u;
    for (;;) {
        sum = 0u; cnt = 0u; mine = 0u;
#pragma unroll
        for (unsigned j = 0; j < 16; ++j) { const unsigned c = xb_ld(&bar[XB_XCNT(j)]); sum += c; cnt += (c > 0u) ? 1u : 0u; mine = (j == x) ? c : mine; }
        if (sum == G) break;
        __builtin_amdgcn_s_sleep(1);
        if ((++sp & 255u) == 0u) { if (xb_ld(&bar[XB_TMO])) break; if (sp > XB_SPIN_CAP) { atomicAdd(&bar[XB_TMO], 1u); break; } }
    }
    nloc = mine > 0u ? mine : 1u; nx = cnt > 0u ? cnt : 1u;
}
DI void xcd_barrier(const XcdBarrier& b) {
    asm volatile("s_waitcnt vmcnt(0)" ::: "memory");
    __syncthreads();
    if (threadIdx.x == 0) {
        unsigned* bar = b.bar;
        __builtin_amdgcn_s_waitcnt(0);
        unsigned nloc = b.st[0], nx = b.st[1];
        if (nloc == 0u) { xcd_barrier_complete(bar, b.x, nloc, nx); b.st[0] = nloc; b.st[1] = nx; }
        const unsigned old = xb_add(&bar[XB_XSUB(b.x)], 1u);
        const unsigned gen = old / nloc;
        if (old + 1u == (gen + 1u) * nloc) {
            __builtin_amdgcn_fence(__ATOMIC_RELEASE, "agent");
            asm volatile("s_waitcnt vmcnt(0)" ::: "memory");
            const unsigned og = xb_add(&bar[XB_TOP], 1u);
            const unsigned tg = og / nx;
            if (og + 1u == (tg + 1u) * nx) xb_add(&bar[XB_TOPGEN], 1u);
            else XB_SPIN(xb_ld(&bar[XB_TOPGEN]) == tg, bar);
            __builtin_amdgcn_fence(__ATOMIC_ACQUIRE, "agent");
            xb_add(&bar[XB_XGEN(b.x)], 1u);
            asm volatile("s_waitcnt vmcnt(0)" ::: "memory");
        } else {
            XB_SPIN(xb_ld(&bar[XB_XGEN(b.x)]) == gen, bar);
            __builtin_amdgcn_fence(__ATOMIC_ACQUIRE, "agent");
            asm volatile("s_waitcnt vmcnt(0)" ::: "memory");
        }
    }
    __syncthreads();
}

DI void transpose_tile(const Ctx& cx, const float* __restrict__ src, int ldsrc, int k0, int n0, bf16_t* __restrict__ dst, int ldd, int dcol0, int drow0, unsigned char* smem,
                       const float* shp = nullptr, float* biasp = nullptr) {
    float* T = (float*)smem;
    const int tid = cx.tid;
    const int kk = tid >> 4, c4 = (tid & 15) * 4;
    f32x4 v[4];
#pragma unroll
    for (int i = 0; i < 4; ++i) v[i] = __builtin_nontemporal_load((const f32x4*)(src + (size_t)(k0 + kk + 16 * i) * ldsrc + n0 + c4));
    __builtin_amdgcn_sched_barrier(0);
#pragma unroll
    for (int i = 0; i < 4; ++i) {
        float* t = T + (kk + 16 * i) * 65 + c4;
        t[0] = v[i][0]; t[1] = v[i][1]; t[2] = v[i][2]; t[3] = v[i][3];
    }
    float* SH = T + 64 * 65;
    if (shp && tid < 192) SH[tid] = shp[(tid >> 6) * 6144 + k0 + (tid & 63)];
    __syncthreads();
    const int nl = tid >> 2, kq = tid & 3;
    float tv[16];
#pragma unroll
    for (int j = 0; j < 16; ++j) tv[j] = T[(kq * 16 + j) * 65 + nl];
    unsigned w[8];
#pragma unroll
    for (int j = 0; j < 8; ++j) w[j] = pack2(tv[2 * j], tv[2 * j + 1]);
    bf16_t* d = dst + wtile_off(drow0 + nl, dcol0 + k0 + kq * 16, ldd);
    *(u32x4*)d = (u32x4){w[0], w[1], w[2], w[3]};
    *(u32x4*)(d + 8) = (u32x4){w[4], w[5], w[6], w[7]};
    if (shp) {
#pragma unroll
        for (int cr = 0; cr < 3; ++cr) {
            float a = 0.f;
#pragma unroll
            for (int q4 = 0; q4 < 4; ++q4) {
                const f32x4 s4 = *(const f32x4*)(SH + cr * 64 + kq * 16 + q4 * 4);
                a += s4[0] * tv[q4 * 4] + s4[1] * tv[q4 * 4 + 1] + s4[2] * tv[q4 * 4 + 2] + s4[3] * tv[q4 * 4 + 3];
            }
            a += __shfl_xor(a, 1); a += __shfl_xor(a, 2);
            if (kq == 0) atomicAdd((int*)biasp + cr * NBIAS + drow0 + nl, (int)lrintf(a * BIAS_SCALE));
        }
    }
    __syncthreads();
}

DI void prologue_transpose(const Ctx& cx, const Params& p, int u, unsigned char* smem) {
    const int l = u / 4816; int i = u % 4816;
    if (i < 1920) { const int kt = i & 15, nt = i >> 4;
        transpose_tile(cx, p.w_in + (size_t)l * DM * NIN, NIN, kt * 64, nt * 64, ((bf16_t*)(p.ws + OFF_WinT)) + (size_t)l * NIN * DM, DM, 0, nt * 64, smem,
                       ((float*)(p.ws + OFF_mod)) + (size_t)l * 3 * 6144, ((float*)(p.ws + OFF_bias)) + (size_t)l * 3 * NBIAS); return; }
    i -= 1920;
    if (i < 512) { const int brn = i >> 7; const int j = i & 127; const int kt = j & 7, nt = j >> 3;
        transpose_tile(cx, p.w_br + ((size_t)l * 4 + brn) * 512 * DM, DM, kt * 64, nt * 64, ((bf16_t*)(p.ws + OFF_WbrT)) + (size_t)l * DM * 2048, 2048, brn * 512, nt * 64, smem); return; }
    i -= 512;
    if (i < 256) { const int kt = i & 15, nt = i >> 4;
        transpose_tile(cx, p.w_o + (size_t)l * DM * DM, DM, kt * 64, nt * 64, ((bf16_t*)(p.ws + OFF_WoT)) + (size_t)l * DM * DM, DM, 0, nt * 64, smem); return; }
    i -= 256;
    if (i < 1408) { const int kt = i & 15, nt = i >> 4;
        const int isb = nt >= 44; const int j0 = (nt - (isb ? 44 : 0)) * 64;
        float* T = (float*)smem;
        const int tid = cx.tid; const int kk = tid >> 4, c4 = (tid & 15) * 4;
        const float* src = p.w_gu + (size_t)l * DM * 2 * DFF;
        f32x4 v[4];
#pragma unroll
        for (int q = 0; q < 4; ++q) v[q] = __builtin_nontemporal_load((const f32x4*)(src + (size_t)(kt * 64 + kk + 16 * q) * (2 * DFF) + nt * 64 + c4));
        __builtin_amdgcn_sched_barrier(0);
#pragma unroll
        for (int q = 0; q < 4; ++q) {
            float* t = T + (kk + 16 * q) * 65 + c4;
            t[0] = v[q][0]; t[1] = v[q][1]; t[2] = v[q][2]; t[3] = v[q][3];
        }
        float* SH = T + 64 * 65;
        if (tid < 192) SH[tid] = ((float*)(p.ws + OFF_mod))[(size_t)(l * 3 + (tid >> 6)) * 6144 + 3072 + kt * 64 + (tid & 63)];
        __syncthreads();
        const int nl = tid >> 2, kq = tid & 3;
        float tv[16];
#pragma unroll
        for (int j = 0; j < 16; ++j) tv[j] = T[(kq * 16 + j) * 65 + nl];
        unsigned w[8];
#pragma unroll
        for (int j = 0; j < 8; ++j) w[j] = pack2(tv[2 * j], tv[2 * j + 1]);
        const int drow = (j0 >> 5) * 64 + isb * 32 + nl + (nl >= 32 ? 32 : 0);
        bf16_t* d = ((bf16_t*)(p.ws + OFF_WguT)) + (size_t)l * 2 * DFF * DM + wtile_off(drow, kt * 64 + kq * 16, DM);
        *(u32x4*)d = (u32x4){w[0], w[1], w[2], w[3]};
        *(u32x4*)(d + 8) = (u32x4){w[4], w[5], w[6], w[7]};
        {
            const int drn = (j0 >> 5) * 64 + isb * 32 + nl + (nl >= 32 ? 32 : 0);
#pragma unroll
            for (int cr = 0; cr < 3; ++cr) {
                float a = 0.f;
#pragma unroll
                for (int q4 = 0; q4 < 4; ++q4) {
                    const f32x4 s4 = *(const f32x4*)(SH + cr * 64 + kq * 16 + q4 * 4);
                    a += s4[0] * tv[q4 * 4] + s4[1] * tv[q4 * 4 + 1] + s4[2] * tv[q4 * 4 + 2] + s4[3] * tv[q4 * 4 + 3];
                }
                a += __shfl_xor(a, 1); a += __shfl_xor(a, 2);
                if (kq == 0) atomicAdd(((int*)(p.ws + OFF_bias)) + (size_t)(l * 3 + cr) * NBIAS + NIN + drn, (int)lrintf(a * BIAS_SCALE));
            }
        }
        __syncthreads();
        return; }
    i -= 1408;
    if (i < 704) { const int kt = i % 44, nt = i / 44;
        transpose_tile(cx, p.w_down + (size_t)l * DFF * DM, DM, kt * 64, nt * 64, ((bf16_t*)(p.ws + OFF_WdT)) + (size_t)l * DM * DFF, DFF, 0, nt * 64, smem); return; }
    i -= 704;
    { const int g = i >> 2; const int kt = i & 1, nt = (i >> 1) & 1;
        transpose_tile(cx, p.pool_w + ((size_t)l * 4 + g) * 128 * 128, 128, kt * 64, nt * 64, ((bf16_t*)(p.ws + OFF_PoolT)) + ((size_t)l * 4 + g) * 128 * 128, 128, 0, nt * 64, smem); }
}

DI void prologue_mod(const Ctx& cx, const Params& p, int u, unsigned char* smem) {
    const int l = u / 96, chunk = u % 96;
    const int tid = cx.tid, cgp = tid & 15, ks = tid >> 4;
    float* S = (float*)smem;
    float* red = S + 3 * 1024;
#pragma unroll
    for (int j = 0; j < 4; ++j) {
        const int k = tid + 256 * j;
        const float c0 = p.c_ctx[k], c1 = p.c[k], c2 = p.c[DM + k];
        S[k] = c0 / (1.f + __expf(-c0)); S[1024 + k] = c1 / (1.f + __expf(-c1)); S[2048 + k] = c2 / (1.f + __expf(-c2));
    }
    __syncthreads();
    const float* w = p.w_mod + (size_t)l * DM * 6144 + chunk * 64 + cgp * 4;
    float a[3][4];
#pragma unroll
    for (int r = 0; r < 3; ++r)
#pragma unroll
        for (int j = 0; j < 4; ++j) a[r][j] = 0.f;
#pragma unroll 1
    for (int kb = 0; kb < 64; kb += 16) {
        f32x4 wv[16];
#pragma unroll
        for (int q = 0; q < 16; ++q) wv[q] = __builtin_nontemporal_load((const f32x4*)(w + (size_t)(ks * 64 + kb + q) * 6144));
        __builtin_amdgcn_sched_barrier(0);
#pragma unroll
        for (int q = 0; q < 16; ++q) {
            const int k = ks * 64 + kb + q;
            const float s0 = S[k], s1 = S[1024 + k], s2 = S[2048 + k];
#pragma unroll
            for (int j = 0; j < 4; ++j) { a[0][j] += s0 * wv[q][j]; a[1][j] += s1 * wv[q][j]; a[2][j] += s2 * wv[q][j]; }
        }
    }
#pragma unroll
    for (int r = 0; r < 3; ++r)
#pragma unroll
        for (int j = 0; j < 4; ++j) red[(ks * 3 + r) * 64 + cgp * 4 + j] = a[r][j];
    __syncthreads();
    if (tid < 192) {
        const int r = tid >> 6, nn = tid & 63;
        float v = p.b_mod[l * 6144 + chunk * 64 + nn];
#pragma unroll
        for (int q = 0; q < 16; ++q) v += red[(q * 3 + r) * 64 + nn];
        ((float*)(p.ws + OFF_mod))[(size_t)(l * 3 + r) * 6144 + chunk * 64 + nn] = v;
    }
    __syncthreads();
}

DI void prologue_misc(const Ctx& cx, const Params& p, int u) {
    const int tid = cx.tid;
    if (u < 768) {
        const f32x4* a = (const f32x4*)p.x_prompt; const f32x4* b = (const f32x4*)p.x_sample; f32x4* o = (f32x4*)p.out;
#pragma unroll
        for (int j = 0; j < 8; ++j) { const int idx = u * 2048 + tid + 256 * j; o[idx] = __builtin_nontemporal_load(idx < 1048576 ? a + idx : b + (idx - 1048576)); }
        return;
    }
    u -= 768;
    if (u < 512) {
        const int e = (u * 256 + tid) * 8;
        const int which = e >> 19, rem = e & ((1 << 19) - 1);
        const int b = rem >> 18, l = (rem >> 16) & 3, s = (rem >> 7) & 511, c = rem & 127;
        const float* src = (which ? p.ck_w : p.ck_a) + rem;
        const f32x4 v0 = __builtin_nontemporal_load((const f32x4*)src), v1 = __builtin_nontemporal_load((const f32x4*)(src + 4));
        bf16_t* dst = (which ? ((bf16_t*)(p.ws + OFF_kCl)) : ((bf16_t*)(p.ws + OFF_kAl))) + ((size_t)((l * 2 + b) * 1536 + s)) * 128 + c;
        *(u32x4*)dst = (u32x4){pack2(v0[0], v0[1]), pack2(v0[2], v0[3]), pack2(v1[0], v1[1]), pack2(v1[2], v1[3])};
        return;
    }
    u -= 512;
    if (u < 64) {
        const int which = u >> 5, l = (u >> 3) & 3, b = (u >> 2) & 1, sp = u & 3;
        const int col = tid & 127, s0 = (sp * 2 + (tid >> 7)) * 64;
        const float* src = (which ? p.cv_w : p.cv_a) + ((size_t)((b * 4 + l) * 512 + s0)) * 128 + col;
        bf16_t* dst = (which ? ((bf16_t*)(p.ws + OFF_vClT)) : ((bf16_t*)(p.ws + OFF_vAlT))) + ((size_t)((l * 2 + b) * 128 + col)) * 1536 + s0;
        float v[64];
#pragma unroll
        for (int j = 0; j < 64; ++j) v[j] = __builtin_nontemporal_load(src + (size_t)j * 128);
        __builtin_amdgcn_sched_barrier(0);
#pragma unroll
        for (int jc = 0; jc < 8; ++jc)
            *(u32x4*)(dst + jc * 8) = (u32x4){pack2(v[jc * 8 + 0], v[jc * 8 + 1]), pack2(v[jc * 8 + 2], v[jc * 8 + 3]), pack2(v[jc * 8 + 4], v[jc * 8 + 5]), pack2(v[jc * 8 + 6], v[jc * 8 + 7])};
        return;
    }
    u -= 64;
    if (u < 51) {
        f32x4* z = (f32x4*)(p.ws + OFF_ssq);
        const int n4 = (int)((WS_TOTAL - OFF_ssq) / 16);
        const float zf = __int_as_float(tid >> 20);
#pragma unroll
        for (int j = 0; j < 4; ++j) { const int idx = u * 1024 + tid + 256 * j; if (idx < n4) z[idx] = (f32x4){zf, zf, zf, zf}; }
        return;
    }
    u -= 51;
    {
#pragma unroll
        for (int j = 0; j < 4; ++j) {
            const int idx = tid + 256 * j; const int pos = idx >> 4, i = idx & 15;
            const float inv = 1.0f / powf(10000.0f, (float)i / 16.0f);
            const float ang = (float)pos * inv;
            ((float*)(p.ws + OFF_rope))[idx] = cosf(ang); ((float*)(p.ws + OFF_rope))[1024 + idx] = sinf(ang);
        }
    }
}
constexpr int PRO_T = 4816, PRO_MOD = 96 * NL, PRO_MISC = 768 + 512 + 64 + 51 + 1;

DI void x0_rows(const Ctx& cx, const Params& p, int r0, int rstride) {
    const int lane = cx.tid & 63;
    f32x4 v[3][4];
#pragma unroll
    for (int q = 0; q < 3; ++q) {
        const f32x4* x = (const f32x4*)(p.out + (size_t)(r0 + q * rstride) * DM);
#pragma unroll
        for (int i = 0; i < 4; ++i) v[q][i] = x[lane + 64 * i];
    }
    f32x4 gv[4];
#pragma unroll
    for (int i = 0; i < 4; ++i) gv[i] = *(const f32x4*)(p.g_mix + (lane + 64 * i) * 4);
    f32x4 scv[3][4];
#pragma unroll
    for (int q = 0; q < 3; ++q)
#pragma unroll
        for (int i = 0; i < 4; ++i) scv[q][i] = *(const f32x4*)(((float*)(p.ws + OFF_mod)) + (size_t)condrow(r0 + q * rstride) * 6144 + DM + (lane + 64 * i) * 4);
    __builtin_amdgcn_sched_barrier(0);
#pragma unroll
    for (int q = 0; q < 3; ++q) {
        const int r = r0 + q * rstride;
        float a = 0.f;
#pragma unroll
        for (int i = 0; i < 4; ++i) a += v[q][i][0] * v[q][i][0] + v[q][i][1] * v[q][i][1] + v[q][i][2] * v[q][i][2] + v[q][i][3] * v[q][i][3];
        a = wave_sum(a);
        if (lane == 0) ((unsigned*)(p.ws + OFF_ssq))[r] = (unsigned)(a * SSQ_SCALE + 0.5f);
#pragma unroll
        for (int i = 0; i < 4; ++i) {
            const int c = (lane + 64 * i) * 4;
            const f32x4 sc = scv[q][i];
            float o[4];
#pragma unroll
            for (int j = 0; j < 4; ++j) o[j] = v[q][i][j] * gv[i][j] * (1.f + sc[j]);
            *(u32x2*)(((bf16_t*)(p.ws + OFF_h)) + wtile_off(r, c, DM)) = (u32x2){pack2(o[0], o[1]), pack2(o[2], o[3])};
        }
    }
}

enum { E_IN = 0, E_BR = 1, E_RES = 2, E_GU = 3, E_POOL = 4 };
struct GemmArgs { const bf16_t* A; int lda; const bf16_t* Bt; int ldb; int K; int row0, col0; int layer; int aux; int atk; };
constexpr int STG_B = 16384;
#define GL_WAIT(n) asm volatile("s_waitcnt vmcnt(" #n ")" ::: "memory")
#define GL_BAR() do { asm volatile("s_waitcnt lgkmcnt(0)" ::: "memory"); __builtin_amdgcn_s_barrier(); } while (0)

template <int EPI> DI void gemm_tile(const Ctx& cx, const Params& p, const GemmArgs& g, unsigned char* smem, bool pre, bool hn, const GemmArgs& gn) {
    const int tid = cx.tid, wid = tid >> 6, lane = tid & 63, l31 = lane & 31, hh = lane >> 5, wm = wid >> 1, wn = wid & 1;
    f32x16 acc[2][2], tot[2][2];
#pragma unroll
    for (int a = 0; a < 2; ++a)
#pragma unroll
        for (int b = 0; b < 2; ++b)
#pragma unroll
            for (int r = 0; r < 16; ++r) { acc[a][b][r] = 0.f; tot[a][b][r] = 0.f; }
    float rs[2][16]; float bcol[2]; float sraw = 0.f;
    if (EPI == E_IN || EPI == E_GU) {
        if (tid < 128) sraw = ((const float*)(p.ws + OFF_ssq))[(size_t)(g.layer * 2 + (EPI == E_GU ? 1 : 0)) * NTOK + g.row0 + tid];
        const float* bp = ((float*)(p.ws + OFF_bias)) + (size_t)(g.layer * 3 + condrow(g.row0)) * NBIAS + (EPI == E_GU ? NIN : 0) + g.col0 + wn * 64 + l31;
        bcol[0] = bp[0]; bcol[1] = bp[32];
    }
    const int nk = g.K >> 5;
    const int lrow = wid * 32 + (lane >> 2);
    const int lsw = (lane & 3) ^ ((lane >> 4) & 3);
    const int lr0 = (g.aux & 16) ? 0 : g.row0, lc0 = (g.aux & 16) ? 0 : g.col0;
    const int ars = g.atk ? 32 : g.lda;
    const size_t aks = g.atk ? 4096 : 32;
    const bf16_t* Ag = g.A + (g.atk ? ((size_t)(lr0 >> 7) * g.atk) * 4096 : (size_t)lr0 * g.lda) + (size_t)lrow * ars + lsw * 8;
    const bf16_t* Bg = g.Bt + ((size_t)(g.col0 >> 7) * (g.K >> 5)) * 4096 + lrow * 32 + lsw * 8;
    const size_t a16 = (size_t)16 * g.lda, b16 = (size_t)16 * g.ldb;
    unsigned char* lbase = smem + wid * 2048;
    auto issue = [&](int kt, int buf) {
        unsigned char* d = lbase + buf * STG_B;
        __builtin_amdgcn_global_load_lds((const unsigned*)(Ag + kt * aks), (unsigned*)d, 16, 0, 0);
        __builtin_amdgcn_global_load_lds((const unsigned*)(Ag + 16 * ars + kt * aks), (unsigned*)(d + 1024), 16, 0, 0);
        __builtin_amdgcn_global_load_lds((const unsigned*)(Bg + (size_t)kt * 4096), (unsigned*)(d + 8192), 16, 0, 0);
        __builtin_amdgcn_global_load_lds((const unsigned*)(Bg + (size_t)kt * 4096 + 512), (unsigned*)(d + 8192 + 1024), 16, 0, 0);
    };
    const int sw = (l31 >> 2) & 3;
    const int offA = (wm * 64 + l31) * 64, offB = 8192 + (wn * 64 + l31) * 64;
    const int c0 = ((0 + hh) ^ sw) * 16, c1 = ((2 + hh) ^ sw) * 16;
    if (!pre) { issue(0, 0); issue(1, 1); issue(2, 2); }
    for (int kt0 = 0; kt0 < nk; kt0 += 4) {
#pragma unroll
        for (int u = 0; u < 4; ++u) {
            const int kt = kt0 + u;
            if (pre && kt == 0) GL_WAIT(0);
            else if (kt + 2 < nk) GL_WAIT(8); else if (kt + 1 < nk) GL_WAIT(4); else GL_WAIT(0);
            GL_BAR();
            const unsigned char* sb = smem + u * STG_B;
            const bf16x8 a00 = *(const bf16x8*)(sb + offA + c0), a10 = *(const bf16x8*)(sb + offA + 2048 + c0);
            const bf16x8 b00 = *(const bf16x8*)(sb + offB + c0), b10 = *(const bf16x8*)(sb + offB + 2048 + c0);
            const bf16x8 a01 = *(const bf16x8*)(sb + offA + c1), a11 = *(const bf16x8*)(sb + offA + 2048 + c1);
            const bf16x8 b01 = *(const bf16x8*)(sb + offB + c1), b11 = *(const bf16x8*)(sb + offB + 2048 + c1);
            __builtin_amdgcn_sched_barrier(0);
            if (kt + 3 < nk) issue(kt + 3, (u + 3) & 3);
            __builtin_amdgcn_sched_barrier(0);
            acc[0][0] = __builtin_amdgcn_mfma_f32_32x32x16_bf16(a00, b00, acc[0][0], 0, 0, 0);
            acc[0][1] = __builtin_amdgcn_mfma_f32_32x32x16_bf16(a00, b10, acc[0][1], 0, 0, 0);
            acc[1][0] = __builtin_amdgcn_mfma_f32_32x32x16_bf16(a10, b00, acc[1][0], 0, 0, 0);
            acc[1][1] = __builtin_amdgcn_mfma_f32_32x32x16_bf16(a10, b10, acc[1][1], 0, 0, 0);
            acc[0][0] = __builtin_amdgcn_mfma_f32_32x32x16_bf16(a01, b01, acc[0][0], 0, 0, 0);
            acc[0][1] = __builtin_amdgcn_mfma_f32_32x32x16_bf16(a01, b11, acc[0][1], 0, 0, 0);
            acc[1][0] = __builtin_amdgcn_mfma_f32_32x32x16_bf16(a11, b01, acc[1][0], 0, 0, 0);
            acc[1][1] = __builtin_amdgcn_mfma_f32_32x32x16_bf16(a11, b11, acc[1][1], 0, 0, 0);
        }
        if (EPI == E_BR && (kt0 & 15) == 12) {
            const int kbr = kt0 >> 4;
            const bf16_t* gp = ((bf16_t*)(p.ws + OFF_gates)) + (size_t)(((g.row0 >> 7) * 4 + kbr) * 8 + (g.col0 >> 7)) * 16384 + tid * 8;
#pragma unroll
            for (int mi = 0; mi < 2; ++mi) {
                u32x4 gw[4];
#pragma unroll
                for (int q = 0; q < 4; ++q) gw[q] = __builtin_nontemporal_load((const u32x4*)(gp + (mi * 4 + q) * 2048));
#pragma unroll
                for (int ni = 0; ni < 2; ++ni)
#pragma unroll
                    for (int r = 0; r < 16; ++r) {
                        const unsigned w = gw[ni * 2 + (r >> 3)][(r & 7) >> 1];
                        const float gv = (r & 1) ? __uint_as_float(w & 0xffff0000u) : __uint_as_float(w << 16);
                        tot[mi][ni][r] += gv * acc[mi][ni][r]; acc[mi][ni][r] = 0.f;
                    }
            }
        }
    }
    if ((EPI == E_IN || EPI == E_GU) && tid < 128)
        ((float*)(smem + 69632))[tid] = rsqrtf((float)__float_as_uint(sraw) * (SSQ_INV / DM) + 1e-6f);
    GL_BAR();
    if (hn) {
        const bf16_t* An = gn.A + (gn.atk ? ((size_t)(gn.row0 >> 7) * gn.atk) * 4096 : (size_t)gn.row0 * gn.lda) + (size_t)lrow * ars + lsw * 8;
        const bf16_t* Bn = gn.Bt + ((size_t)(gn.col0 >> 7) * (gn.K >> 5)) * 4096 + lrow * 32 + lsw * 8;
#pragma unroll
        for (int st = 0; st < 3; ++st) {
            unsigned char* d = lbase + st * STG_B;
            __builtin_amdgcn_global_load_lds((const unsigned*)(An + st * aks), (unsigned*)d, 16, 0, 0);
            __builtin_amdgcn_global_load_lds((const unsigned*)(An + 16 * ars + st * aks), (unsigned*)(d + 1024), 16, 0, 0);
            __builtin_amdgcn_global_load_lds((const unsigned*)(Bn + (size_t)st * 4096), (unsigned*)(d + 8192), 16, 0, 0);
            __builtin_amdgcn_global_load_lds((const unsigned*)(Bn + (size_t)st * 4096 + 512), (unsigned*)(d + 8192 + 1024), 16, 0, 0);
        }
    }
    if (EPI == E_IN || EPI == E_GU) {
#pragma unroll
        for (int mi = 0; mi < 2; ++mi)
#pragma unroll
            for (int r4 = 0; r4 < 4; ++r4) {
                const f32x4 q4 = *(const f32x4*)((const float*)(smem + 69632) + wm * 64 + mi * 32 + 8 * r4 + 4 * hh);
                rs[mi][4 * r4 + 0] = q4[0]; rs[mi][4 * r4 + 1] = q4[1]; rs[mi][4 * r4 + 2] = q4[2]; rs[mi][4 * r4 + 3] = q4[3];
            }
        bcol[0] = (float)__float_as_int(bcol[0]) * BIAS_INV; bcol[1] = (float)__float_as_int(bcol[1]) * BIAS_INV;
    }
    if (EPI == E_IN && g.col0 >= NPR) {
        const int gc = g.col0 - NPR;
        bf16_t* gp = ((bf16_t*)(p.ws + OFF_gates)) + (size_t)(((g.row0 >> 7) * 4 + (gc >> 10)) * 8 + ((gc & 1023) >> 7)) * 16384 + tid * 8;
#pragma unroll
        for (int mi = 0; mi < 2; ++mi)
#pragma unroll
            for (int ni = 0; ni < 2; ++ni) {
                float sg[16]; f32x16 xv;
#pragma unroll
                for (int r = 0; r < 16; ++r) xv[r] = acc[mi][ni][r] * rs[mi][r] + bcol[ni];
                sigmoid16(xv, sg);
                *(u32x4*)(gp + ((mi * 2 + ni) * 2) * 2048) = (u32x4){pack2(sg[0], sg[1]), pack2(sg[2], sg[3]), pack2(sg[4], sg[5]), pack2(sg[6], sg[7])};
                *(u32x4*)(gp + ((mi * 2 + ni) * 2 + 1) * 2048) = (u32x4){pack2(sg[8], sg[9]), pack2(sg[10], sg[11]), pack2(sg[12], sg[13]), pack2(sg[14], sg[15])};
            }
        return;
    }
    if (EPI == E_IN || EPI == E_GU || EPI == E_BR) {
        constexpr int OW = (EPI == E_GU) ? 64 : 128;
        constexpr int OS = OW + 8;
        constexpr int NH = (EPI == E_GU) ? 1 : 2;
        constexpr int RH = 128 / NH;
        constexpr int CPR = OW / 8;
        constexpr int OLD = (EPI == E_GU) ? DFF : (EPI == E_BR) ? DM : NPR;
        bf16_t* T = (bf16_t*)(smem + 3 * STG_B);
        bf16_t* O = (EPI == E_GU) ? ((bf16_t*)(p.ws + OFF_act)) + (size_t)g.row0 * DFF + (g.col0 >> 1)
                  : (EPI == E_BR) ? ((bf16_t*)(p.ws + OFF_merged)) + (size_t)g.row0 * DM + g.col0
                                  : ((bf16_t*)(p.ws + OFF_P)) + (size_t)g.row0 * NPR + g.col0;
#pragma unroll
        for (int hf = 0; hf < NH; ++hf) {
            if (NH == 1 || wm == hf) {
#pragma unroll
                for (int mi = 0; mi < 2; ++mi) {
                    float sg[16];
                    if (EPI == E_GU) {
                        f32x16 av;
#pragma unroll
                        for (int r = 0; r < 16; ++r) av[r] = acc[mi][0][r] * rs[mi][r] + bcol[0];
                        sigmoid16(av, sg);
#pragma unroll
                        for (int r = 0; r < 16; ++r) sg[r] = av[r] * sg[r] * (acc[mi][1][r] * rs[mi][r] + bcol[1]);
                    }
#pragma unroll
                    for (int r = 0; r < 16; ++r) {
                        const int rl = (NH == 1 ? wm * 64 : 0) + mi * 32 + (r & 3) + 8 * (r >> 2) + 4 * hh;
                        if (EPI == E_GU) {
                            T[rl * OS + wn * 32 + l31] = f2bf(sg[r]);
                        } else if (EPI == E_BR) {
                            T[rl * OS + wn * 64 + l31] = f2bf(tot[mi][0][r]);
                            T[rl * OS + wn * 64 + 32 + l31] = f2bf(tot[mi][1][r]);
                        } else {
                            T[rl * OS + wn * 64 + l31] = f2bf(acc[mi][0][r] * rs[mi][r] + bcol[0]);
                            T[rl * OS + wn * 64 + 32 + l31] = f2bf(acc[mi][1][r] * rs[mi][r] + bcol[1]);
                        }
                    }
                }
            }
            GL_BAR();
#pragma unroll
            for (int i = 0; i < (RH * CPR) / 256; ++i) {
                const int ch = tid + 256 * i; const int rr = ch / CPR, cc = ch % CPR;
                bf16_t* od;
                if (EPI == E_GU) od = ((bf16_t*)(p.ws + OFF_act)) + wtile_off(g.row0 + hf * RH + rr, (g.col0 >> 1) + cc * 8, DFF);
                else if (EPI == E_BR) od = ((bf16_t*)(p.ws + OFF_merged)) + wtile_off(g.row0 + hf * RH + rr, g.col0 + cc * 8, DM);
                else od = O + (size_t)(hf * RH + rr) * OLD + cc * 8;
                *(u32x4*)od = *(const u32x4*)(T + rr * OS + cc * 8);
            }
            GL_BAR();
        }
        return;
    }
    if (EPI == E_RES) {
        const int cr = condrow(g.row0), which = g.aux & 7;
        const bool mk = (which == 2) || (g.layer + 1 < NL);
        const int nl = which == 2 ? g.layer : g.layer + 1;
        const float* modc = ((float*)(p.ws + OFF_mod)) + (size_t)(g.layer * 3 + cr) * 6144 + which * DM;
        float gm[2];
        gm[0] = modc[g.col0 + wn * 64 + l31]; gm[1] = modc[g.col0 + wn * 64 + 32 + l31];
        const int cq = tid & 31;
        f32x4 gn4 = (f32x4){0.f, 0.f, 0.f, 0.f};
        if (mk) {
            const f32x4 gg = *(const f32x4*)((which == 2 ? p.g_ffn : p.g_mix) + nl * DM + g.col0 + cq * 4);
            const f32x4 sc = *(const f32x4*)(((float*)(p.ws + OFF_mod)) + (size_t)(nl * 3 + cr) * 6144 + (which == 2 ? 4 : 1) * DM + g.col0 + cq * 4);
            gn4 = gg * (1.f + sc);
        }
        unsigned* ssq = ((unsigned*)(p.ws + OFF_ssq)) + (size_t)(nl * 2 + (which == 2 ? 1 : 0)) * NTOK;
        float* Dl = (float*)smem;
#pragma unroll
        for (int mi = 0; mi < 2; ++mi) {
            f32x4 xo[8];
#pragma unroll
            for (int i = 0; i < 8; ++i) {
                const int rr = (tid >> 5) + 8 * i;
                xo[i] = *(const f32x4*)((const float*)(p.out) + (size_t)(g.row0 + (rr >> 5) * 64 + mi * 32 + (rr & 31)) * DM + g.col0 + cq * 4);
            }
#pragma unroll
            for (int r = 0; r < 16; ++r) {
                const int rl = wm * 32 + (r & 3) + 8 * (r >> 2) + 4 * hh;
                Dl[rl * 132 + wn * 64 + l31] = gm[0] * acc[mi][0][r];
                Dl[rl * 132 + wn * 64 + 32 + l31] = gm[1] * acc[mi][1][r];
            }
            GL_BAR();
#pragma unroll
            for (int i = 0; i < 8; ++i) {
                const int rr = (tid >> 5) + 8 * i;
                const int row = g.row0 + (rr >> 5) * 64 + mi * 32 + (rr & 31);
                const f32x4 xn = xo[i] + *(const f32x4*)(Dl + rr * 132 + cq * 4);
                *(f32x4*)((float*)(p.out) + (size_t)row * DM + g.col0 + cq * 4) = xn;
                if (mk) {
                    const f32x4 hv = xn * gn4;
                    *(u32x2*)(((bf16_t*)(p.ws + OFF_h)) + wtile_off(row, g.col0 + cq * 4, DM)) = (u32x2){pack2(hv[0], hv[1]), pack2(hv[2], hv[3])};
                    float sq = xn[0] * xn[0] + xn[1] * xn[1] + xn[2] * xn[2] + xn[3] * xn[3];
#pragma unroll
                    for (int o2 = 16; o2 >= 1; o2 >>= 1) sq += __shfl_xor(sq, o2);
                    if (cq == 0) atomicAdd(ssq + row, (unsigned)(sq * SSQ_SCALE + 0.5f));
                }
            }
            GL_BAR();
        }
        return;
    }
#pragma unroll
    for (int mi = 0; mi < 2; ++mi)
#pragma unroll
        for (int r = 0; r < 16; ++r) {
            const int row = g.row0 + wm * 64 + mi * 32 + (r & 3) + 8 * (r >> 2) + 4 * hh;
            if (EPI == E_GU) {
                const float a = acc[mi][0][r], b = acc[mi][1][r];
                const int ac = ((g.col0 + wn * 64) >> 1) + l31;
                ((bf16_t*)(p.ws + OFF_act))[(size_t)row * DFF + ac] = f2bf(a / (1.f + __expf(-a)) * b);
            } else {
#pragma unroll
                for (int ni = 0; ni < 2; ++ni) {
                    const int col = g.col0 + wn * 64 + ni * 32 + l31;
                    const float v = acc[mi][ni][r];
                    if (EPI == E_IN) {
                        ((float*)(p.ws + OFF_P))[(size_t)row * NPR + col] = v;
                    } else if (EPI == E_BR) {
                        ((bf16_t*)(p.ws + OFF_merged))[(size_t)row * DM + col] = f2bf(tot[mi][ni][r]);
                    } else if (EPI == E_RES) {
                        const float gm = ((float*)(p.ws + OFF_mod))[(size_t)(g.layer * 3 + condrow(row)) * 6144 + (g.aux & 7) * DM + col];
                        __attribute__((address_space(1))) float* o = p.out + (size_t)row * DM + col;
                        if (!(g.aux & 8)) *o = *o + gm * v;
                    } else if (EPI == E_POOL) {
                        ((bf16_t*)(p.ws + OFF_br))[wtile_off(row, 1536 + g.aux * 128 + col, 2048)] = f2bf(v * p.pool_scale[g.layer * 512 + g.aux * 128 + col]);
                    }
                }
            }
        }
}

template <int EPI> DI void gemm_phase(const Ctx& cx, const Params& p, int layer, const bf16_t* A, int lda, const bf16_t* Bt, int ldb, int K, int N, int aux, unsigned char* smem) {
    const int nM = NTOK / 128, nN = N / 128;
    const int x = cx.bid & 7, j = cx.bid >> 3, J = gridDim.x >> 3;
    GemmArgs g; g.A = A; g.lda = lda; g.Bt = Bt; g.ldb = ldb; g.K = K; g.layer = layer; g.aux = aux; g.atk = K >> 5;
    if (nN == 8) {
        for (int t = j; t < (nM / 8) * 8; t += J) {
            g.row0 = ((t >> 3) * 8 + x) * 128; g.col0 = (t & 7) * 128;
            gemm_tile<EPI>(cx, p, g, smem, false, false, g);
        }
        return;
    }
    const int SN = J >> 3;
    const int nSM = nM / 8, nSN = (nN + SN - 1) / SN;
    GemmArgs gnx = g;
    int st = x; bool have = false;
    for (; st < nSM * nSN; st += 8) { const int pn = (st / nSM) * SN + (j >> 3); if (pn < nN) { g.row0 = ((st % nSM) * 8 + (j & 7)) * 128; g.col0 = pn * 128; have = true; st += 8; break; } }
    bool pre = false;
    while (have) {
        bool hn = false;
        for (; st < nSM * nSN; st += 8) { const int pn = (st / nSM) * SN + (j >> 3); if (pn < nN) { gnx.row0 = ((st % nSM) * 8 + (j & 7)) * 128; gnx.col0 = pn * 128; hn = true; st += 8; break; } }
        gemm_tile<EPI>(cx, p, g, smem, pre, hn, gnx);
        pre = hn; have = hn; g.row0 = gnx.row0; g.col0 = gnx.col0;
    }
}

DI void post_vunit(const Ctx& cx, const Params& p, int layer, int vt) {
    const int tid = cx.tid; const int pc = tid & 63, which = (tid >> 6) & 1, th = tid >> 7, col = 2 * pc;
    const int r0 = vt * 64 + th * 32;
    const bf16_t* src = ((bf16_t*)(p.ws + OFF_P)) + (size_t)r0 * NPR + (which ? 1408 : 640) + col;
    bf16_t* dst; size_t dstride; __attribute__((address_space(1))) float* of = nullptr;
    if (r0 < NCTX) { const int b = r0 >> 8, t0 = r0 & 255;
        dst = (which ? ((bf16_t*)(p.ws + OFF_vCcT)) : ((bf16_t*)(p.ws + OFF_vAcT))) + ((size_t)(b * 128 + col)) * 256 + t0; dstride = 256;
        of = p.out + (which ? OUT_VW : OUT_VA) + ((size_t)((b * 4 + layer) * 256 + t0)) * 128 + col;
    } else { const int b = (r0 - NCTX) >> 10, t0 = (r0 - NCTX) & 1023;
        dst = (which ? ((bf16_t*)(p.ws + OFF_vClT)) : ((bf16_t*)(p.ws + OFF_vAlT))) + ((size_t)((layer * 2 + b) * 128 + col)) * 1536 + 512 + t0; dstride = 1536;
    }
    unsigned raw[32];
#pragma unroll
    for (int j = 0; j < 32; ++j) raw[j] = __builtin_nontemporal_load((const unsigned*)(src + (size_t)j * NPR));
    __builtin_amdgcn_sched_barrier(0);
    if (of) {
#pragma unroll
        for (int j = 0; j < 32; ++j) {
            typedef float f32x2 __attribute__((ext_vector_type(2)));
            __builtin_nontemporal_store((f32x2){__uint_as_float(raw[j] << 16), __uint_as_float(raw[j] & 0xffff0000u)}, (__attribute__((address_space(1))) f32x2*)(of + (size_t)j * 128));
        }
    }
#pragma unroll
    for (int jc = 0; jc < 4; ++jc) {
        unsigned lo[4], hi[4];
#pragma unroll
        for (int q = 0; q < 4; ++q) {
            const unsigned a = raw[jc * 8 + 2 * q], b2 = raw[jc * 8 + 2 * q + 1];
            lo[q] = (a & 0xffffu) | (b2 << 16);
            hi[q] = (a >> 16) | (b2 & 0xffff0000u);
        }
        *(u32x4*)(dst + jc * 8) = (u32x4){lo[0], lo[1], lo[2], lo[3]};
        *(u32x4*)(dst + dstride + jc * 8) = (u32x4){hi[0], hi[1], hi[2], hi[3]};
    }
}

DI void post_row(const Ctx& cx, const Params& p, int layer, int r) {
    const int lane = cx.tid & 63;
    const bf16_t* Pr = ((bf16_t*)(p.ws + OFF_P)) + (size_t)r * NPR;
    const bool lat = r >= NCTX;
    int b, t, T;
    if (lat) { b = (r - NCTX) >> 10; t = (r - NCTX) & 1023; T = 1024; } else { b = r >> 8; t = r & 255; T = 256; }
    const int lh = lane & 31;
    unsigned hraw[10];
#pragma unroll
    for (int hp = 0; hp < 10; ++hp) {
        const int col = hp < 4 ? hp * 128 : hp == 4 ? 512 : hp < 9 ? 768 + (hp - 5) * 128 : 1280;
        hraw[hp] = *(const unsigned*)(Pr + col + 2 * lane);
    }
    float cs[2] = {1.f, 1.f}, sn[2] = {0.f, 0.f};
    if (lat) {
        const float* rp = (float*)(p.ws + OFF_rope);
        const int pos = (lh < 16) ? (t >> 6) : (t & 63); const int i0 = (2 * lh) & 15;
        cs[0] = rp[pos * 16 + i0]; cs[1] = rp[pos * 16 + i0 + 1]; sn[0] = rp[1024 + pos * 16 + i0]; sn[1] = rp[1024 + pos * 16 + i0 + 1];
        if (!(lh & 8)) { sn[0] = -sn[0]; sn[1] = -sn[1]; }
    }
    float gsel4[4][2];
    gsel4[0][0] = p.gq_a[layer * 64 + 2 * lh]; gsel4[0][1] = p.gq_a[layer * 64 + 2 * lh + 1];
    gsel4[1][0] = p.gk_a[layer * 64 + 2 * lh]; gsel4[1][1] = p.gk_a[layer * 64 + 2 * lh + 1];
    gsel4[2][0] = p.gq_c[layer * 64 + 2 * lh]; gsel4[2][1] = p.gq_c[layer * 64 + 2 * lh + 1];
    gsel4[3][0] = p.gk_c[layer * 64 + 2 * lh]; gsel4[3][1] = p.gk_c[layer * 64 + 2 * lh + 1];
#pragma unroll
    for (int hp = 0; hp < 10; ++hp) {
        const int typ = hp < 4 ? 0 : hp == 4 ? 1 : hp < 9 ? 2 : 3;
        const bool isk = typ & 1; const int which = typ >> 1;
        const float v0 = __uint_as_float(hraw[hp] << 16), v1 = __uint_as_float(hraw[hp] & 0xffff0000u);
        float ss = v0 * v0 + v1 * v1;
#pragma unroll
        for (int o = 16; o >= 1; o >>= 1) ss += __shfl_xor(ss, o);
        const float rn = rsqrtf(ss * (1.0f / 64.f) + 1e-6f);
        float y0 = v0 * rn * gsel4[typ][0], y1 = v1 * rn * gsel4[typ][1];
        if (lat) { const float p0 = __shfl_xor(y0, 8), p1 = __shfl_xor(y1, 8); y0 = y0 * cs[0] + p0 * sn[0]; y1 = y1 * cs[1] + p1 * sn[1]; }
        if (!isk) {
            const int qh0 = (which ? hp - 5 : hp) * 2;
            *(unsigned*)(((bf16_t*)(p.ws + (which ? OFF_qC : OFF_qA))) + (size_t)r * 512 + qh0 * 64 + 2 * lane) = pack2(y0 * QSCALE, y1 * QSCALE);
        } else if (!lat) {
            *(unsigned*)(((bf16_t*)(p.ws + (which ? OFF_kCc : OFF_kAc))) + (size_t)r * 128 + 2 * lane) = pack2(y0, y1);
            __attribute__((address_space(1))) float* ok = p.out + (which ? OUT_KW : OUT_KA) + ((size_t)((b * 4 + layer) * 256 + t)) * 128 + 2 * lane;
            __builtin_nontemporal_store(y0, ok); __builtin_nontemporal_store(y1, ok + 1);
        } else {
            *(unsigned*)(((bf16_t*)(p.ws + (which ? OFF_kCl : OFF_kAl))) + ((size_t)((layer * 2 + b) * 1536 + 512 + t)) * 128 + 2 * lane) = pack2(y0, y1);
        }
    }
    asm volatile("" ::: "memory");
    const float mm = (t > 0) ? 1.f : 0.f, mp = (t < T - 1) ? 1.f : 0.f;
    const bf16_t* Pm = Pr - ((t > 0) ? NPR : 0);
    const bf16_t* Pp = Pr + ((t < T - 1) ? NPR : 0);
    const float* cw = p.conv_w + layer * 3 * 512;
#pragma unroll
    for (int half = 0; half < 2; ++half) {
        float yc[2][2], ym[2][2];
#pragma unroll
        for (int ii = 0; ii < 2; ++ii) {
            const int i = half * 2 + ii;
            const int c = i * 128 + 2 * lane;
            const unsigned gc0 = *(const unsigned*)(Pr + 2560 + c), u0 = *(const unsigned*)(Pr + 1536 + c);
            const unsigned gcm = *(const unsigned*)(Pm + 2560 + c), um = *(const unsigned*)(Pm + 1536 + c);
            const unsigned gcp = *(const unsigned*)(Pp + 2560 + c), up = *(const unsigned*)(Pp + 1536 + c);
            const unsigned gb = *(const unsigned*)(Pr + 2048 + c);
            const float w0[2] = {cw[c], cw[c + 1]}, w1[2] = {cw[512 + c], cw[512 + c + 1]}, w2[2] = {cw[1024 + c], cw[1024 + c + 1]};
            const int hw = 1 << i;
            int lo = t - hw; lo = lo < 0 ? 0 : lo;
            int hi = t + hw; hi = hi > T ? T : hi;
            float sacc[2] = {0.f, 0.f}; unsigned pf = 0u;
#pragma unroll
            for (int q = -hw; q < hw; ++q) {
                const int tq = t + q; const bool ok = tq >= 0 && tq < T;
                const int dq = ok ? q : 0;
                const unsigned w = *(const unsigned*)(Pr + (ptrdiff_t)dq * NPR + 3072 + c);
                const float okf = ok ? 1.f : 0.f;
                sacc[0] += __uint_as_float(w << 16) * okf; sacc[1] += __uint_as_float(w & 0xffff0000u) * okf;
                if (q == 0) pf = w;
            }
            const float rn = 1.0f / (float)(hi - lo);
#pragma unroll
            for (int e = 0; e < 2; ++e) {
                auto sel = [&](unsigned w) { return e ? __uint_as_float(w & 0xffff0000u) : __uint_as_float(w << 16); };
                const float z0 = sel(gc0) * sel(u0), zm = sel(gcm) * sel(um) * mm, zp = sel(gcp) * sel(up) * mp;
                yc[ii][e] = sel(gb) * (zm * w0[e] + z0 * w1[e] + zp * w2[e]);
                ym[ii][e] = sacc[e] * rn - sel(pf);
            }
        }
#pragma unroll
        for (int ii = 0; ii < 2; ++ii) {
            const int c = (half * 2 + ii) * 128 + 2 * lane;
            *(unsigned*)(((bf16_t*)(p.ws + OFF_br)) + wtile_off(r, 512 + c, 2048)) = pack2(yc[ii][0], yc[ii][1]);
            *(unsigned*)(((bf16_t*)(p.ws + OFF_ypool)) + (size_t)r * 512 + c) = pack2(ym[ii][0], ym[ii][1]);
        }
        asm volatile("" ::: "memory");
    }
}

constexpr int KSTR = 72, VSTR = 68;
constexpr int ATT_BUF_E = 64 * KSTR + 64 * VSTR;
DI void attn_unit(const Ctx& cx, const Params& p, int layer, int kind, int b, int head, int qb, unsigned char* smem) {
    const int tid = cx.tid, wid = tid >> 6, lane = tid & 63, ql = lane & 31, hh = lane >> 5;
    const bool isC = kind & 1, isLat = kind >= 2;
    const int kvh = head >> 2;
    const int qrow = (isLat ? NCTX + b * 1024 : b * 256) + qb * 128 + wid * 32 + ql;
    const bf16_t* Kp; const bf16_t* Vt; int S;
    if (!isLat) { S = 256; Kp = (isC ? ((bf16_t*)(p.ws + OFF_kCc)) : ((bf16_t*)(p.ws + OFF_kAc))) + (size_t)b * 256 * 128 + kvh * 64; Vt = (isC ? ((bf16_t*)(p.ws + OFF_vCcT)) : ((bf16_t*)(p.ws + OFF_vAcT))) + (size_t)((b * 2 + kvh) * 64) * 256; }
    else { S = 1536; Kp = (isC ? ((bf16_t*)(p.ws + OFF_kCl)) : ((bf16_t*)(p.ws + OFF_kAl))) + (size_t)((layer * 2 + b) * 1536) * 128 + kvh * 64; Vt = (isC ? ((bf16_t*)(p.ws + OFF_vClT)) : ((bf16_t*)(p.ws + OFF_vAlT))) + (size_t)(((layer * 2 + b) * 2 + kvh) * 64) * 1536; }
    int nt1 = S / 64, t2lo = 0, t2hi = 0;
    if (kind == 3) { nt1 = 8; const int i0 = qb * 128; const int jlo = i0 - 128 < 0 ? 0 : i0 - 128; const int jhi = i0 + 256 > 1024 ? 1024 : i0 + 256; t2lo = 8 + (jlo >> 6); t2hi = 8 + (jhi >> 6); }
    const int ntiles = nt1 + (t2hi - t2lo);
    bf16x8 qf[4];
    { const bf16_t* q = (isC ? ((bf16_t*)(p.ws + OFF_qC)) : ((bf16_t*)(p.ws + OFF_qA))) + (size_t)qrow * 512 + head * 64 + hh * 8;
#pragma unroll
      for (int ks = 0; ks < 4; ++ks) qf[ks] = *(const bf16x8*)(q + ks * 16); }
    bf16_t* L = (bf16_t*)smem;
    const int sr = tid >> 3, scc = (tid & 7) * 8;
    u32x4 rk[2], rv[2];
    auto gload = [&](int it) {
        const int kt = it < nt1 ? it : t2lo + (it - nt1);
#pragma unroll
        for (int i = 0; i < 2; ++i) {
            rk[i] = *(const u32x4*)(Kp + (size_t)(kt * 64 + sr + 32 * i) * 128 + scc);
            rv[i] = *(const u32x4*)(Vt + (size_t)(sr + 32 * i) * S + kt * 64 + scc);
        }
    };
    auto lstore = [&](int buf) {
        bf16_t* Ks = L + buf * ATT_BUF_E; bf16_t* Vs = Ks + 64 * KSTR;
#pragma unroll
        for (int i = 0; i < 2; ++i) {
            *(u32x4*)(Ks + (sr + 32 * i) * KSTR + scc) = rk[i];
            u32x2* vd = (u32x2*)(Vs + (sr + 32 * i) * VSTR + scc);
            vd[0] = (u32x2){rv[i][0], rv[i][1]}; vd[1] = (u32x2){rv[i][2], rv[i][3]};
        }
    };
    f32x16 ot[2];
#pragma unroll
    for (int r = 0; r < 16; ++r) { ot[0][r] = 0.f; ot[1][r] = 0.f; }
    float m = -1e30f, lsum = 0.f;
    const int qpos = qb * 128 + wid * 32 + ql;
    gload(0); lstore(0); __syncthreads();
    for (int it = 0; it < ntiles; ++it) {
        const int buf = it & 1;
        if (it + 1 < ntiles) gload(it + 1);
        const bf16_t* Ks = L + buf * ATT_BUF_E; const bf16_t* Vs = Ks + 64 * KSTR;
        f32x16 st[2];
#pragma unroll
        for (int j = 0; j < 2; ++j) {
#pragma unroll
            for (int r = 0; r < 16; ++r) st[j][r] = 0.f;
#pragma unroll
            for (int ks = 0; ks < 4; ++ks) {
                const bf16x8 a = *(const bf16x8*)(Ks + (j * 32 + ql) * KSTR + ks * 16 + hh * 8);
                st[j] = __builtin_amdgcn_mfma_f32_32x32x16_bf16(a, qf[ks], st[j], 0, 0, 0);
            }
        }
        if (kind == 3 && it >= nt1) {
            const int kt = t2lo + (it - nt1);
            const int jbase = kt * 64 - 512;
#pragma unroll
            for (int j = 0; j < 2; ++j)
#pragma unroll
                for (int r = 0; r < 16; ++r) {
                    const int jp = jbase + j * 32 + (r & 3) + 8 * (r >> 2) + 4 * hh;
                    const int d = qpos - jp;
                    if (d > 128 || d < -128) st[j][r] = -1e30f;
                }
        }
        float mx = st[0][0];
#pragma unroll
        for (int j = 0; j < 2; ++j)
#pragma unroll
            for (int r = 0; r < 16; ++r) mx = fmaxf(mx, st[j][r]);
        mx = fmaxf(mx, __shfl_xor(mx, 32));
        const float mn = fmaxf(m, mx);
        const float alpha = __builtin_amdgcn_exp2f(m - mn);
        m = mn;
        float ps = 0.f;
#pragma unroll
        for (int j = 0; j < 2; ++j)
#pragma unroll
            for (int r = 0; r < 16; ++r) { const float e = __builtin_amdgcn_exp2f(st[j][r] - mn); st[j][r] = e; ps += e; }
        lsum = lsum * alpha + ps;
#pragma unroll
        for (int r = 0; r < 16; ++r) { ot[0][r] *= alpha; ot[1][r] *= alpha; }
#pragma unroll
        for (int j = 0; j < 2; ++j)
#pragma unroll
            for (int s2 = 0; s2 < 2; ++s2) {
                const u32x4 pw = (u32x4){pack2(st[j][8 * s2 + 0], st[j][8 * s2 + 1]), pack2(st[j][8 * s2 + 2], st[j][8 * s2 + 3]),
                                         pack2(st[j][8 * s2 + 4], st[j][8 * s2 + 5]), pack2(st[j][8 * s2 + 6], st[j][8 * s2 + 7])};
                const bf16x8 pf = __builtin_bit_cast(bf16x8, pw);
#pragma unroll
                for (int db = 0; db < 2; ++db) {
                    const bf16_t* vp = Vs + (db * 32 + ql) * VSTR + j * 32 + s2 * 16 + 4 * hh;
                    const s16x4 lo = *(const s16x4*)vp, hi = *(const s16x4*)(vp + 8);
                    const bf16x8 vf = __builtin_shufflevector(lo, hi, 0, 1, 2, 3, 4, 5, 6, 7);
                    ot[db] = __builtin_amdgcn_mfma_f32_32x32x16_bf16(vf, pf, ot[db], 0, 0, 0);
                }
            }
        if (it + 1 < ntiles) lstore(buf ^ 1);
        __syncthreads();
    }
    float lt = lsum + __shfl_xor(lsum, 32);
    float oscale = 1.f;
    if (isC) {
        const float sk = p.sink[layer * 8 + head] * LOG2E;
        const float mf = fmaxf(m, sk);
        oscale = __builtin_amdgcn_exp2f(m - mf);
        lt = lt * oscale + __builtin_amdgcn_exp2f(sk - mf);
    }
    const float inv = oscale / lt;
    bf16_t* o = ((bf16_t*)(p.ws + OFF_br)) + wtile_off(qrow, (isC ? 1024 : 0) + head * 64, 2048);
#pragma unroll
    for (int db = 0; db < 2; ++db)
#pragma unroll
        for (int g4 = 0; g4 < 4; ++g4) {
            const int d = db * 32 + 8 * g4 + 4 * hh;
            *(u32x2*)(o + db * 4096 + 8 * g4 + 4 * hh) = (u32x2){pack2(ot[db][4 * g4 + 0] * inv, ot[db][4 * g4 + 1] * inv), pack2(ot[db][4 * g4 + 2] * inv, ot[db][4 * g4 + 3] * inv)};
        }
}

DI void idle_transposes(const Ctx& cx, const Params& p, int layer, int part, unsigned char* smem) {
    if (layer + 1 >= NL) return;
    const int lo = part == 1 ? 0 : part == 2 ? 1640 : 2510, hi = part == 1 ? 1640 : part == 2 ? 2510 : 4816;
    unsigned* qctr = (unsigned*)(p.ws + OFF_bar) + 3856 + (layer * 4 + part) * 8;
    volatile unsigned* slot = (volatile unsigned*)(smem + 73696);
    for (;;) {
        __syncthreads();
        if (cx.tid == 0) *slot = atomicAdd(qctr, 1u);
        __syncthreads();
        const int t = (int)*slot;
        if (t >= hi - lo) break;
        prologue_transpose(cx, p, (layer + 1) * 4816 + lo + t, smem);
    }
}

DI void run_phase(const Ctx& cx, const Params& p, int ph, unsigned char* smem, int dry) {
    const int tid = cx.tid, wid = tid >> 6;
    if (ph < 2) {
        const int total = ph == 0 ? PRO_MOD + PRO_MISC + 1488 : 3328 + 512;
        for (int u = cx.bid; u < total; u += gridDim.x) {
            int ti = -1;
            if (ph == 0) {
                if (u < PRO_MOD) prologue_mod(cx, p, u, smem);
                else if (u < PRO_MOD + PRO_MISC) prologue_misc(cx, p, u - PRO_MOD);
                else { const int i = u - PRO_MOD - PRO_MISC; ti = i < 768 ? 1920 + i : 4096 + (i - 768); }
            } else {
                if (u < 3328) ti = u < 1920 ? u : 2688 + (u - 1920);
                else x0_rows(cx, p, (u - 3328) * 4 + wid, 2048);
            }
            if (ti >= 0) prologue_transpose(cx, p, ti, smem);
        }
        return;
    }
    const int layer = (ph - 2) / 7, sub = (ph - 2) % 7;
    switch (sub) {
    case 0: gemm_phase<E_IN>(cx, p, layer, ((bf16_t*)(p.ws + OFF_h)), DM, ((bf16_t*)(p.ws + OFF_WinT)) + (size_t)layer * NIN * DM, DM, DM, NPR, 0, smem); break;
    case 1: for (int u = cx.bid; u < 96 + 1536; u += gridDim.x) { if (u < 96) post_vunit(cx, p, layer, u); else post_row(cx, p, layer, (u - 96) * 4 + wid); } break;
    case 2:
        for (int u = cx.bid; u < 960; u += gridDim.x) {
            if (u < 128) attn_unit(cx, p, layer, 2, u >> 6, (u >> 3) & 7, u & 7, smem);
            else if (u < 256) { const int v = u - 128; attn_unit(cx, p, layer, 3, v >> 6, (v >> 3) & 7, v & 7, smem); }
            else if (u < 512) { const int v = u - 256; attn_unit(cx, p, layer, 0, v >> 4, (v >> 1) & 7, v & 1, smem); }
            else if (u < 768) { const int v = u - 512; attn_unit(cx, p, layer, 1, v >> 4, (v >> 1) & 7, v & 1, smem); }
            else { const int v = u - 768; const int pm = v >> 2, grp = v & 3;
                GemmArgs g; g.A = ((bf16_t*)(p.ws + OFF_ypool)) + grp * 128; g.lda = 512; g.Bt = ((bf16_t*)(p.ws + OFF_PoolT)) + (size_t)(layer * 4 + grp) * 16384; g.ldb = 128; g.K = 128; g.row0 = pm * 128; g.col0 = 0; g.layer = layer; g.aux = grp; g.atk = 0;
                gemm_tile<E_POOL>(cx, p, g, smem, false, false, g); }
        }
        if (!dry) {
            unsigned* qctr = (unsigned*)(p.ws + OFF_bar) + 3600 + (layer * 2 + dry) * 32;
            volatile unsigned* slot = (volatile unsigned*)(smem + 73696);
            GemmArgs g, gnx; g.A = (bf16_t*)(p.ws + OFF_h); g.lda = DM; g.Bt = ((bf16_t*)(p.ws + OFF_WinT)) + (size_t)layer * NIN * DM; g.ldb = DM; g.K = DM; g.layer = layer; g.aux = 0; g.atk = DM >> 5;
            gnx = g;
            __syncthreads();
            if (tid == 0) *slot = atomicAdd(qctr, 1u);
            __syncthreads();
            unsigned t = *slot; bool pre = false;
            while (t < 1536u) {
                __syncthreads();
                if (tid == 0) *slot = atomicAdd(qctr, 1u);
                __syncthreads();
                const unsigned tn = *slot;
                g.row0 = (int)(t % 48u) * 128; g.col0 = NPR + (int)(t / 48u) * 128;
                const bool hn = tn < 1536u;
                if (hn) { gnx.row0 = (int)(tn % 48u) * 128; gnx.col0 = NPR + (int)(tn / 48u) * 128; }
                gemm_tile<E_IN>(cx, p, g, smem, pre, hn, gnx);
                pre = hn; t = tn;
            }
        }
        break;
    case 3: gemm_phase<E_BR>(cx, p, layer, ((bf16_t*)(p.ws + OFF_br)), 2048, ((bf16_t*)(p.ws + OFF_WbrT)) + (size_t)layer * DM * 2048, 2048, 2048, DM, 0, smem); break;
    case 4: gemm_phase<E_RES>(cx, p, layer, ((bf16_t*)(p.ws + OFF_merged)), DM, ((bf16_t*)(p.ws + OFF_WoT)) + (size_t)layer * DM * DM, DM, DM, DM, 2, smem); break;
    case 5: gemm_phase<E_GU>(cx, p, layer, ((bf16_t*)(p.ws + OFF_h)), DM, ((bf16_t*)(p.ws + OFF_WguT)) + (size_t)layer * 2 * DFF * DM, DM, DM, 2 * DFF, 0, smem); break;
    case 6: gemm_phase<E_RES>(cx, p, layer, ((bf16_t*)(p.ws + OFF_act)), DFF, ((bf16_t*)(p.ws + OFF_WdT)) + (size_t)layer * DM * DFF, DFF, DFF, DM, 5, smem); break;
    }
    if (sub == 3 || sub == 4 || sub == 6) idle_transposes(cx, p, layer, sub == 3 ? 1 : sub == 4 ? 2 : 3, smem);
}

__global__ void __launch_bounds__(256, 2) fwd_megakernel(Params p) {
    __shared__ __attribute__((aligned(16))) unsigned char smem[73728];
#if MK_MULTI
    Ctx cx; cx.tid = threadIdx.x; cx.bid = blockIdx.x;
    run_phase(cx, p, p.phase_lo, smem, 0);
#else
    if (threadIdx.x == 0) *(uint4*)(smem + 73712) = make_uint4(0u, 0u, 0u, 0u);
    __syncthreads();
    XcdBarrier xb = xcd_barrier_post((unsigned*)(p.ws + OFF_bar), (volatile LAS unsigned*)(smem + 73712));
    if (p.phase_lo < 0) cg::this_grid().sync();
    for (int ph = p.phase_lo; ph < p.phase_hi; ++ph) {
        Ctx cx; cx.tid = threadIdx.x; cx.bid = blockIdx.x;
        asm volatile("" : "+v"(cx.tid));
        asm volatile("" : "+s"(cx.bid));
        Params q = p;
        asm volatile("" : "+s"(q.ws));
        asm volatile("" : "+s"(q.out));
        run_phase(cx, q, ph, smem, 0);
        if (ph + 1 < p.phase_hi) xcd_barrier(xb);
#if PROBE2
        if (ph >= 2) { const int sub = (ph - 2) % 7;
            if (((PROBE2 & 1) && sub == 0) || ((PROBE2 & 2) && sub == 1) || ((PROBE2 & 8) && sub == 5)) { run_phase(cx, q, ph, smem, 0); xcd_barrier(xb); }
            if ((PROBE2 & 4) && sub == 1) { run_phase(cx, q, ph + 1, smem, 1); xcd_barrier(xb); } }
#endif
    }
#endif
}

extern "C" void kernel_launch(void* const* d_in, const int* in_sizes, int n_in, void* d_out, int out_size, void* d_ws, size_t ws_size, hipStream_t stream) {
    Params p; memset(&p, 0, sizeof(p));
    const float* const* in = (const float* const*)d_in;
    p.x_prompt = in[0]; p.x_sample = in[1]; p.ck_a = in[2]; p.cv_a = in[3]; p.ck_w = in[4]; p.cv_w = in[5]; p.c = in[6]; p.c_ctx = in[7];
    p.w_mod = in[8]; p.b_mod = in[9]; p.g_mix = in[10]; p.g_ffn = in[11]; p.w_in = in[12]; p.gq_a = in[13]; p.gk_a = in[14]; p.gq_c = in[15]; p.gk_c = in[16];
    p.sink = in[17]; p.conv_w = in[18]; p.pool_w = in[19]; p.pool_scale = in[20]; p.w_br = in[21]; p.w_o = in[22]; p.w_gu = in[23]; p.w_down = in[24];
    p.out = (__attribute__((address_space(1))) float*)d_out;
    p.ws = (__attribute__((address_space(1))) unsigned char*)d_ws;
    if (WS_TOTAL > ws_size) { fprintf(stderr, "workspace too small: need %zu have %zu\n", (size_t)WS_TOTAL, ws_size); return; }
#if MK_MULTI
    for (int ph = 0; ph < NPHASE; ++ph) {
        p.phase_lo = ph; p.phase_hi = ph + 1;
        hipLaunchKernelGGL(fwd_megakernel, dim3(512), dim3(256), 0, stream, p);
    }
#else
    static int grid_blocks = 0;
    if (!grid_blocks) {
        int dev = 0, cus = 0, per_cu = 0;
        hipGetDevice(&dev);
        hipDeviceGetAttribute(&cus, hipDeviceAttributeMultiprocessorCount, dev);
        hipOccupancyMaxActiveBlocksPerMultiprocessor(&per_cu, fwd_megakernel, 256, 0);
        if (per_cu > 2) per_cu = 2;
        if (per_cu < 1) per_cu = 1;
        grid_blocks = cus * per_cu;
    }
    p.phase_lo = 0; p.phase_hi = NPHASE;
    (void)hipMemsetAsync((unsigned char*)d_ws + OFF_bar, 0, 16384, stream);
    void* args[] = {&p};
    hipError_t e = hipLaunchCooperativeKernel((void*)fwd_megakernel, dim3(grid_blocks), dim3(256), args, 0, stream);
    if (e != hipSuccess) fprintf(stderr, "cooperative launch failed: %s (grid %d)\n", hipGetErrorString(e), grid_blocks);
#endif
}
```

```cpp
#include <hip/hip_runtime.h>
#include <hip/hip_cooperative_groups.h>
#include <cstdio>
#include <cstdint>
#include <cstring>
namespace cg = cooperative_groups;

#ifndef PROBE2
#define PROBE2 0
#endif
#ifndef PROBE_REP
#define PROBE_REP 0
#endif
#ifndef PROBE_DRYBITS
#define PROBE_DRYBITS 8
#endif
#ifndef MK_MULTI
#define MK_MULTI 0
#endif

typedef unsigned short bf16_t;
typedef short bf16x8 __attribute__((ext_vector_type(8)));
typedef short s16x4 __attribute__((ext_vector_type(4)));
typedef float f32x16 __attribute__((ext_vector_type(16)));
typedef float f32x4 __attribute__((ext_vector_type(4)));
typedef unsigned u32x4 __attribute__((ext_vector_type(4)));
typedef unsigned u32x2 __attribute__((ext_vector_type(2)));
#define DI __device__ __forceinline__
#define LAS __attribute__((address_space(3)))

constexpr int NTOK = 6144, NCTX = 4096, DM = 1024, NIN = 7680, NPR = 3584, DFF = 2816, NL = 4;
constexpr float LOG2E = 1.4426950408889634f;
constexpr float QSCALE = 0.125f * LOG2E;
constexpr size_t OUT_KA = 6291456, OUT_VA = 8388608, OUT_KW = 10485760, OUT_VW = 12582912;
constexpr int NPHASE = 2 + 7 * NL;
constexpr float SSQ_SCALE = 256.f, SSQ_INV = 1.0f / 256.f, BIAS_SCALE = 16777216.f, BIAS_INV = 1.0f / 16777216.f;
constexpr int NBIAS = NIN + 2 * DFF;

constexpr size_t al256(size_t x) { return (x + 255) & ~(size_t)255; }
constexpr size_t OFF_bar = 0;
constexpr size_t OFF_mod = OFF_bar + al256(16384);
constexpr size_t OFF_rope = OFF_mod + al256((size_t)NL * 3 * 6144 * 4);
constexpr size_t OFF_WinT = OFF_rope + al256(2048 * 4);
constexpr size_t OFF_WbrT = OFF_WinT + al256((size_t)NL * NIN * DM * 2);
constexpr size_t OFF_WoT = OFF_WbrT + al256((size_t)NL * DM * 2048 * 2);
constexpr size_t OFF_WguT = OFF_WoT + al256((size_t)NL * DM * DM * 2);
constexpr size_t OFF_WdT = OFF_WguT + al256((size_t)NL * 2 * DFF * DM * 2);
constexpr size_t OFF_PoolT = OFF_WdT + al256((size_t)NL * DM * DFF * 2);
constexpr size_t OFF_h = OFF_PoolT + al256((size_t)NL * 4 * 128 * 128 * 2);
constexpr size_t OFF_P = OFF_h + al256((size_t)NTOK * DM * 2);
constexpr size_t OFF_gates = OFF_P + al256((size_t)NTOK * NPR * 4);
constexpr size_t OFF_qA = OFF_gates + al256((size_t)NTOK * 4096 * 2);
constexpr size_t OFF_qC = OFF_qA + al256((size_t)NTOK * 512 * 2);
constexpr size_t OFF_kAc = OFF_qC + al256((size_t)NTOK * 512 * 2);
constexpr size_t OFF_kCc = OFF_kAc + al256((size_t)NCTX * 128 * 2);
constexpr size_t OFF_kAl = OFF_kCc + al256((size_t)NCTX * 128 * 2);
constexpr size_t OFF_kCl = OFF_kAl + al256((size_t)NL * 2 * 1536 * 128 * 2);
constexpr size_t OFF_vAcT = OFF_kCl + al256((size_t)NL * 2 * 1536 * 128 * 2);
constexpr size_t OFF_vCcT = OFF_vAcT + al256((size_t)NCTX * 128 * 2);
constexpr size_t OFF_vAlT = OFF_vCcT + al256((size_t)NCTX * 128 * 2);
constexpr size_t OFF_vClT = OFF_vAlT + al256((size_t)NL * 2 * 1536 * 128 * 2);
constexpr size_t OFF_ypool = OFF_vClT + al256((size_t)NL * 2 * 1536 * 128 * 2);
constexpr size_t OFF_br = OFF_ypool + al256((size_t)NTOK * 512 * 2);
constexpr size_t OFF_merged = OFF_br + al256((size_t)NTOK * 2048 * 2);
constexpr size_t OFF_act = OFF_merged + al256((size_t)NTOK * DM * 2);
constexpr size_t OFF_ssq = OFF_act + al256((size_t)NTOK * DFF * 2);
constexpr size_t OFF_bias = OFF_ssq + al256((size_t)NL * 2 * NTOK * 4);
constexpr size_t WS_TOTAL = OFF_bias + al256((size_t)NL * 3 * NBIAS * 4);

struct Ctx { int tid, bid; };
struct Params {
    const float *x_prompt, *x_sample, *ck_a, *cv_a, *ck_w, *cv_w, *c, *c_ctx;
    const float *w_mod, *b_mod, *g_mix, *g_ffn, *w_in, *gq_a, *gk_a, *gq_c, *gk_c, *sink, *conv_w, *pool_w, *pool_scale, *w_br, *w_o, *w_gu, *w_down;
    __attribute__((address_space(1))) float* out;
    __attribute__((address_space(1))) unsigned char* ws;
    int phase_lo, phase_hi;
};

DI bf16_t f2bf(float x) { return __builtin_bit_cast(unsigned short, (__bf16)x); }
DI float bf2f(bf16_t v) { return __uint_as_float(((unsigned)v) << 16); }
DI unsigned pack2(float lo, float hi) {
    typedef __bf16 bf2 __attribute__((ext_vector_type(2)));
    typedef float f2 __attribute__((ext_vector_type(2)));
    f2 x = {lo, hi};
    return __builtin_bit_cast(unsigned, __builtin_convertvector(x, bf2));
}
DI size_t wtile_off(int n, int k, int K) { return ((size_t)(n >> 7) * (K >> 5) + (k >> 5)) * 4096 + (n & 127) * 32 + (k & 31); }
DI float wave_sum(float v) {
#pragma unroll
    for (int o = 32; o >= 1; o >>= 1) v += __shfl_xor(v, o);
    return v;
}
DI float fsigmoid(float x) { return __builtin_amdgcn_rcpf(1.f + __builtin_amdgcn_exp2f(-LOG2E * x)); }
DI void sigmoid16(const f32x16& x, float (&o)[16]) {
#pragma unroll
    for (int r = 0; r < 16; ++r) o[r] = x[r] * (-LOG2E);
    __builtin_amdgcn_sched_barrier(0);
#pragma unroll
    for (int r = 0; r < 16; ++r) o[r] = __builtin_amdgcn_exp2f(o[r]);
    __builtin_amdgcn_sched_barrier(0);
#pragma unroll
    for (int r = 0; r < 16; ++r) o[r] = 1.f + o[r];
#pragma unroll
    for (int r = 0; r < 16; ++r) o[r] = __builtin_amdgcn_rcpf(o[r]);
    __builtin_amdgcn_sched_barrier(0);
}
DI int condrow(int r) { return r < NCTX ? 0 : 1 + ((r - NCTX) >> 10); }

#define XB_TMO      128
#define XB_XCNT(j)  (256  + 64 * (j))
#define XB_XSUB(j)  (1280 + 64 * (j))
#define XB_XGEN(j)  (2304 + 64 * (j))
#define XB_TOP      3328
#define XB_TOPGEN   3392
#define XCD_BAR_WORDS 3456
#define XB_SPIN_CAP (1u << 22)
DI unsigned xb_ld(unsigned* p) { return __hip_atomic_load(p, __ATOMIC_RELAXED, __HIP_MEMORY_SCOPE_AGENT); }
DI unsigned xb_add(unsigned* p, unsigned v) { return __hip_atomic_fetch_add(p, v, __ATOMIC_RELAXED, __HIP_MEMORY_SCOPE_AGENT); }
DI unsigned xb_xcc_id() { return (unsigned)__builtin_amdgcn_s_getreg((3 << 11) | 20) & 0xFu; }
#define XB_SPIN(cond, bar) do { unsigned _sp = 0; while (cond) { __builtin_amdgcn_s_sleep(1); \
    if ((++_sp & 255u) == 0u) { if (xb_ld(&(bar)[XB_TMO])) break; if (_sp > XB_SPIN_CAP) { atomicAdd(&(bar)[XB_TMO], 1u); break; } } } } while (0)
struct XcdBarrier { unsigned* bar; unsigned x; volatile LAS unsigned* st; };
DI XcdBarrier xcd_barrier_post(unsigned* bar, volatile LAS unsigned* st) {
    XcdBarrier b; b.bar = bar; b.x = xb_xcc_id(); b.st = st;
    if (threadIdx.x == 0) (void)xb_add(&bar[XB_XCNT(b.x)], 1u);
    return b;
}
DI void xcd_barrier_complete(unsigned* bar, unsigned x, unsigned& nloc, unsigned& nx) {
    const unsigned G = gridDim.x * gridDim.y * gridDim.z;
    unsigned sum, cnt, mine, sp = 0u;
    for (;;) {
        sum = 0u; cnt = 0u; mine = 0u;
#pragma unroll
        for (unsigned j = 0; j < 16; ++j) { const unsigned c = xb_ld(&bar[XB_XCNT(j)]); sum += c; cnt += (c > 0u) ? 1u : 0u; mine = (j == x) ? c : mine; }
        if (sum == G) break;
        __builtin_amdgcn_s_sleep(1);
        if ((++sp & 255u) == 0u) { if (xb_ld(&bar[XB_TMO])) break; if (sp > XB_SPIN_CAP) { atomicAdd(&bar[XB_TMO], 1u); break; } }
    }
    nloc = mine > 0u ? mine : 1u; nx = cnt > 0u ? cnt : 1u;
}
DI void xcd_barrier(const XcdBarrier& b) {
    asm volatile("s_waitcnt vmcnt(0)" ::: "memory");
    __syncthreads();
    if (threadIdx.x == 0) {
        unsigned* bar = b.bar;
        __builtin_amdgcn_s_waitcnt(0);
        unsigned nloc = b.st[0], nx = b.st[1];
        if (nloc == 0u) { xcd_barrier_complete(bar, b.x, nloc, nx); b.st[0] = nloc; b.st[1] = nx; }
        const unsigned old = xb_add(&bar[XB_XSUB(b.x)], 1u);
        const unsigned gen = old / nloc;
        if (old + 1u == (gen + 1u) * nloc) {
            __builtin_amdgcn_fence(__ATOMIC_RELEASE, "agent");
            asm volatile("s_waitcnt vmcnt(0)" ::: "memory");
            const unsigned og = xb_add(&bar[XB_TOP], 1u);
            const unsigned tg = og / nx;
            if (og + 1u == (tg + 1u) * nx) xb_add(&bar[XB_TOPGEN], 1u);
            else XB_SPIN(xb_ld(&bar[XB_TOPGEN]) == tg, bar);
            __builtin_amdgcn_fence(__ATOMIC_ACQUIRE, "agent");
            xb_add(&bar[XB_XGEN(b.x)], 1u);
            asm volatile("s_waitcnt vmcnt(0)" ::: "memory");
        } else {
            XB_SPIN(xb_ld(&bar[XB_XGEN(b.x)]) == gen, bar);
            __builtin_amdgcn_fence(__ATOMIC_ACQUIRE, "agent");
            asm volatile("s_waitcnt vmcnt(0)" ::: "memory");
        }
    }
    __syncthreads();
}

DI void transpose_tile(const Ctx& cx, const float* __restrict__ src, int ldsrc, int k0, int n0, bf16_t* __restrict__ dst, int ldd, int dcol0, int drow0, unsigned char* smem,
                       const float* shp = nullptr, float* biasp = nullptr) {
    float* T = (float*)smem;
    const int tid = cx.tid;
    const int kk = tid >> 4, c4 = (tid & 15) * 4;
    f32x4 v[4];
#pragma unroll
    for (int i = 0; i < 4; ++i) v[i] = __builtin_nontemporal_load((const f32x4*)(src + (size_t)(k0 + kk + 16 * i) * ldsrc + n0 + c4));
    __builtin_amdgcn_sched_barrier(0);
#pragma unroll
    for (int i = 0; i < 4; ++i) {
        float* t = T + (kk + 16 * i) * 65 + c4;
        t[0] = v[i][0]; t[1] = v[i][1]; t[2] = v[i][2]; t[3] = v[i][3];
    }
    float* SH = T + 64 * 65;
    if (shp && tid < 192) SH[tid] = shp[(tid >> 6) * 6144 + k0 + (tid & 63)];
    __syncthreads();
    const int nl = tid >> 2, kq = tid & 3;
    float tv[16];
#pragma unroll
    for (int j = 0; j < 16; ++j) tv[j] = T[(kq * 16 + j) * 65 + nl];
    unsigned w[8];
#pragma unroll
    for (int j = 0; j < 8; ++j) w[j] = pack2(tv[2 * j], tv[2 * j + 1]);
    bf16_t* d = dst + wtile_off(drow0 + nl, dcol0 + k0 + kq * 16, ldd);
    *(u32x4*)d = (u32x4){w[0], w[1], w[2], w[3]};
    *(u32x4*)(d + 8) = (u32x4){w[4], w[5], w[6], w[7]};
    if (shp) {
#pragma unroll
        for (int cr = 0; cr < 3; ++cr) {
            float a = 0.f;
#pragma unroll
            for (int q4 = 0; q4 < 4; ++q4) {
                const f32x4 s4 = *(const f32x4*)(SH + cr * 64 + kq * 16 + q4 * 4);
                a += s4[0] * tv[q4 * 4] + s4[1] * tv[q4 * 4 + 1] + s4[2] * tv[q4 * 4 + 2] + s4[3] * tv[q4 * 4 + 3];
            }
            a += __shfl_xor(a, 1); a += __shfl_xor(a, 2);
            if (kq == 0) atomicAdd((int*)biasp + cr * NBIAS + drow0 + nl, (int)lrintf(a * BIAS_SCALE));
        }
    }
    __syncthreads();
}

DI void prologue_transpose(const Ctx& cx, const Params& p, int u, unsigned char* smem) {
    const int l = u / 4816; int i = u % 4816;
    if (i < 1920) { const int kt = i & 15, nt = i >> 4;
        transpose_tile(cx, p.w_in + (size_t)l * DM * NIN, NIN, kt * 64, nt * 64, ((bf16_t*)(p.ws + OFF_WinT)) + (size_t)l * NIN * DM, DM, 0, nt * 64, smem,
                       ((float*)(p.ws + OFF_mod)) + (size_t)l * 3 * 6144, ((float*)(p.ws + OFF_bias)) + (size_t)l * 3 * NBIAS); return; }
    i -= 1920;
    if (i < 512) { const int brn = i >> 7; const int j = i & 127; const int kt = j & 7, nt = j >> 3;
        transpose_tile(cx, p.w_br + ((size_t)l * 4 + brn) * 512 * DM, DM, kt * 64, nt * 64, ((bf16_t*)(p.ws + OFF_WbrT)) + (size_t)l * DM * 2048, 2048, brn * 512, nt * 64, smem); return; }
    i -= 512;
    if (i < 256) { const int kt = i & 15, nt = i >> 4;
        transpose_tile(cx, p.w_o + (size_t)l * DM * DM, DM, kt * 64, nt * 64, ((bf16_t*)(p.ws + OFF_WoT)) + (size_t)l * DM * DM, DM, 0, nt * 64, smem); return; }
    i -= 256;
    if (i < 1408) { const int kt = i & 15, nt = i >> 4;
        const int isb = nt >= 44; const int j0 = (nt - (isb ? 44 : 0)) * 64;
        float* T = (float*)smem;
        const int tid = cx.tid; const int kk = tid >> 4, c4 = (tid & 15) * 4;
        const float* src = p.w_gu + (size_t)l * DM * 2 * DFF;
        f32x4 v[4];
#pragma unroll
        for (int q = 0; q < 4; ++q) v[q] = __builtin_nontemporal_load((const f32x4*)(src + (size_t)(kt * 64 + kk + 16 * q) * (2 * DFF) + nt * 64 + c4));
        __builtin_amdgcn_sched_barrier(0);
#pragma unroll
        for (int q = 0; q < 4; ++q) {
            float* t = T + (kk + 16 * q) * 65 + c4;
            t[0] = v[q][0]; t[1] = v[q][1]; t[2] = v[q][2]; t[3] = v[q][3];
        }
        float* SH = T + 64 * 65;
        if (tid < 192) SH[tid] = ((float*)(p.ws + OFF_mod))[(size_t)(l * 3 + (tid >> 6)) * 6144 + 3072 + kt * 64 + (tid & 63)];
        __syncthreads();
        const int nl = tid >> 2, kq = tid & 3;
        float tv[16];
#pragma unroll
        for (int j = 0; j < 16; ++j) tv[j] = T[(kq * 16 + j) * 65 + nl];
        unsigned w[8];
#pragma unroll
        for (int j = 0; j < 8; ++j) w[j] = pack2(tv[2 * j], tv[2 * j + 1]);
        const int drow = (j0 >> 5) * 64 + isb * 32 + nl + (nl >= 32 ? 32 : 0);
        bf16_t* d = ((bf16_t*)(p.ws + OFF_WguT)) + (size_t)l * 2 * DFF * DM + wtile_off(drow, kt * 64 + kq * 16, DM);
        *(u32x4*)d = (u32x4){w[0], w[1], w[2], w[3]};
        *(u32x4*)(d + 8) = (u32x4){w[4], w[5], w[6], w[7]};
        {
            const int drn = (j0 >> 5) * 64 + isb * 32 + nl + (nl >= 32 ? 32 : 0);
#pragma unroll
            for (int cr = 0; cr < 3; ++cr) {
                float a = 0.f;
#pragma unroll
                for (int q4 = 0; q4 < 4; ++q4) {
                    const f32x4 s4 = *(const f32x4*)(SH + cr * 64 + kq * 16 + q4 * 4);
                    a += s4[0] * tv[q4 * 4] + s4[1] * tv[q4 * 4 + 1] + s4[2] * tv[q4 * 4 + 2] + s4[3] * tv[q4 * 4 + 3];
                }
                a += __shfl_xor(a, 1); a += __shfl_xor(a, 2);
                if (kq == 0) atomicAdd(((int*)(p.ws + OFF_bias)) + (size_t)(l * 3 + cr) * NBIAS + NIN + drn, (int)lrintf(a * BIAS_SCALE));
            }
        }
        __syncthreads();
        return; }
    i -= 1408;
    if (i < 704) { const int kt = i % 44, nt = i / 44;
        transpose_tile(cx, p.w_down + (size_t)l * DFF * DM, DM, kt * 64, nt * 64, ((bf16_t*)(p.ws + OFF_WdT)) + (size_t)l * DM * DFF, DFF, 0, nt * 64, smem); return; }
    i -= 704;
    { const int g = i >> 2; const int kt = i & 1, nt = (i >> 1) & 1;
        transpose_tile(cx, p.pool_w + ((size_t)l * 4 + g) * 128 * 128, 128, kt * 64, nt * 64, ((bf16_t*)(p.ws + OFF_PoolT)) + ((size_t)l * 4 + g) * 128 * 128, 128, 0, nt * 64, smem); }
}

DI void prologue_mod(const Ctx& cx, const Params& p, int u, unsigned char* smem) {
    const int l = u / 96, chunk = u % 96;
    const int tid = cx.tid, cgp = tid & 15, ks = tid >> 4;
    float* S = (float*)smem;
    float* red = S + 3 * 1024;
#pragma unroll
    for (int j = 0; j < 4; ++j) {
        const int k = tid + 256 * j;
        const float c0 = p.c_ctx[k], c1 = p.c[k], c2 = p.c[DM + k];
        S[k] = c0 / (1.f + __expf(-c0)); S[1024 + k] = c1 / (1.f + __expf(-c1)); S[2048 + k] = c2 / (1.f + __expf(-c2));
    }
    __syncthreads();
    const float* w = p.w_mod + (size_t)l * DM * 6144 + chunk * 64 + cgp * 4;
    float a[3][4];
#pragma unroll
    for (int r = 0; r < 3; ++r)
#pragma unroll
        for (int j = 0; j < 4; ++j) a[r][j] = 0.f;
#pragma unroll 1
    for (int kb = 0; kb < 64; kb += 16) {
        f32x4 wv[16];
#pragma unroll
        for (int q = 0; q < 16; ++q) wv[q] = __builtin_nontemporal_load((const f32x4*)(w + (size_t)(ks * 64 + kb + q) * 6144));
        __builtin_amdgcn_sched_barrier(0);
#pragma unroll
        for (int q = 0; q < 16; ++q) {
            const int k = ks * 64 + kb + q;
            const float s0 = S[k], s1 = S[1024 + k], s2 = S[2048 + k];
#pragma unroll
            for (int j = 0; j < 4; ++j) { a[0][j] += s0 * wv[q][j]; a[1][j] += s1 * wv[q][j]; a[2][j] += s2 * wv[q][j]; }
        }
    }
#pragma unroll
    for (int r = 0; r < 3; ++r)
#pragma unroll
        for (int j = 0; j < 4; ++j) red[(ks * 3 + r) * 64 + cgp * 4 + j] = a[r][j];
    __syncthreads();
    if (tid < 192) {
        const int r = tid >> 6, nn = tid & 63;
        float v = p.b_mod[l * 6144 + chunk * 64 + nn];
#pragma unroll
        for (int q = 0; q < 16; ++q) v += red[(q * 3 + r) * 64 + nn];
        ((float*)(p.ws + OFF_mod))[(size_t)(l * 3 + r) * 6144 + chunk * 64 + nn] = v;
    }
    __syncthreads();
}

DI void prologue_misc(const Ctx& cx, const Params& p, int u) {
    const int tid = cx.tid;
    if (u < 768) {
        const f32x4* a = (const f32x4*)p.x_prompt; const f32x4* b = (const f32x4*)p.x_sample; f32x4* o = (f32x4*)p.out;
#pragma unroll
        for (int j = 0; j < 8; ++j) { const int idx = u * 2048 + tid + 256 * j; o[idx] = __builtin_nontemporal_load(idx < 1048576 ? a + idx : b + (idx - 1048576)); }
        return;
    }
    u -= 768;
    if (u < 512) {
        const int e = (u * 256 + tid) * 8;
        const int which = e >> 19, rem = e & ((1 << 19) - 1);
        const int b = rem >> 18, l = (rem >> 16) & 3, s = (rem >> 7) & 511, c = rem & 127;
        const float* src = (which ? p.ck_w : p.ck_a) + rem;
        const f32x4 v0 = *(const f32x4*)src, v1 = *(const f32x4*)(src + 4);
        bf16_t* dst = (which ? ((bf16_t*)(p.ws + OFF_kCl)) : ((bf16_t*)(p.ws + OFF_kAl))) + ((size_t)((l * 2 + b) * 1536 + s)) * 128 + c;
        *(u32x4*)dst = (u32x4){pack2(v0[0], v0[1]), pack2(v0[2], v0[3]), pack2(v1[0], v1[1]), pack2(v1[2], v1[3])};
        return;
    }
    u -= 512;
    if (u < 64) {
        const int which = u >> 5, l = (u >> 3) & 3, b = (u >> 2) & 1, sp = u & 3;
        const int col = tid & 127, s0 = (sp * 2 + (tid >> 7)) * 64;
        const float* src = (which ? p.cv_w : p.cv_a) + ((size_t)((b * 4 + l) * 512 + s0)) * 128 + col;
        bf16_t* dst = (which ? ((bf16_t*)(p.ws + OFF_vClT)) : ((bf16_t*)(p.ws + OFF_vAlT))) + ((size_t)((l * 2 + b) * 128 + col)) * 1536 + s0;
        float v[64];
#pragma unroll
        for (int j = 0; j < 64; ++j) v[j] = src[(size_t)j * 128];
        __builtin_amdgcn_sched_barrier(0);
#pragma unroll
        for (int jc = 0; jc < 8; ++jc)
            *(u32x4*)(dst + jc * 8) = (u32x4){pack2(v[jc * 8 + 0], v[jc * 8 + 1]), pack2(v[jc * 8 + 2], v[jc * 8 + 3]), pack2(v[jc * 8 + 4], v[jc * 8 + 5]), pack2(v[jc * 8 + 6], v[jc * 8 + 7])};
        return;
    }
    u -= 64;
    if (u < 51) {
        f32x4* z = (f32x4*)(p.ws + OFF_ssq);
        const int n4 = (int)((WS_TOTAL - OFF_ssq) / 16);
        const float zf = __int_as_float(tid >> 20);
#pragma unroll
        for (int j = 0; j < 4; ++j) { const int idx = u * 1024 + tid + 256 * j; if (idx < n4) z[idx] = (f32x4){zf, zf, zf, zf}; }
        return;
    }
    u -= 51;
    {
#pragma unroll
        for (int j = 0; j < 4; ++j) {
            const int idx = tid + 256 * j; const int pos = idx >> 4, i = idx & 15;
            const float inv = 1.0f / powf(10000.0f, (float)i / 16.0f);
            const float ang = (float)pos * inv;
            ((float*)(p.ws + OFF_rope))[idx] = cosf(ang); ((float*)(p.ws + OFF_rope))[1024 + idx] = sinf(ang);
        }
    }
}
constexpr int PRO_T = 4816, PRO_MOD = 96 * NL, PRO_MISC = 768 + 512 + 64 + 51 + 1;

DI void x0_rows(const Ctx& cx, const Params& p, int r0, int rstride) {
    const int lane = cx.tid & 63;
    f32x4 v[3][4];
#pragma unroll
    for (int q = 0; q < 3; ++q) {
        const f32x4* x = (const f32x4*)(p.out + (size_t)(r0 + q * rstride) * DM);
#pragma unroll
        for (int i = 0; i < 4; ++i) v[q][i] = x[lane + 64 * i];
    }
    f32x4 gv[4];
#pragma unroll
    for (int i = 0; i < 4; ++i) gv[i] = *(const f32x4*)(p.g_mix + (lane + 64 * i) * 4);
    f32x4 scv[3][4];
#pragma unroll
    for (int q = 0; q < 3; ++q)
#pragma unroll
        for (int i = 0; i < 4; ++i) scv[q][i] = *(const f32x4*)(((float*)(p.ws + OFF_mod)) + (size_t)condrow(r0 + q * rstride) * 6144 + DM + (lane + 64 * i) * 4);
    __builtin_amdgcn_sched_barrier(0);
#pragma unroll
    for (int q = 0; q < 3; ++q) {
        const int r = r0 + q * rstride;
        float a = 0.f;
#pragma unroll
        for (int i = 0; i < 4; ++i) a += v[q][i][0] * v[q][i][0] + v[q][i][1] * v[q][i][1] + v[q][i][2] * v[q][i][2] + v[q][i][3] * v[q][i][3];
        a = wave_sum(a);
        if (lane == 0) ((unsigned*)(p.ws + OFF_ssq))[r] = (unsigned)(a * SSQ_SCALE + 0.5f);
#pragma unroll
        for (int i = 0; i < 4; ++i) {
            const int c = (lane + 64 * i) * 4;
            const f32x4 sc = scv[q][i];
            float o[4];
#pragma unroll
            for (int j = 0; j < 4; ++j) o[j] = v[q][i][j] * gv[i][j] * (1.f + sc[j]);
            *(u32x2*)(((bf16_t*)(p.ws + OFF_h)) + wtile_off(r, c, DM)) = (u32x2){pack2(o[0], o[1]), pack2(o[2], o[3])};
        }
    }
}

enum { E_IN = 0, E_BR = 1, E_RES = 2, E_GU = 3, E_POOL = 4 };
struct GemmArgs { const bf16_t* A; int lda; const bf16_t* Bt; int ldb; int K; int row0, col0; int layer; int aux; int atk; };
constexpr int STG_B = 16384;
#define GL_WAIT(n) asm volatile("s_waitcnt vmcnt(" #n ")" ::: "memory")
#define GL_BAR() do { asm volatile("s_waitcnt lgkmcnt(0)" ::: "memory"); __builtin_amdgcn_s_barrier(); } while (0)

template <int EPI> DI void gemm_tile(const Ctx& cx, const Params& p, const GemmArgs& g, unsigned char* smem, bool pre, bool hn, const GemmArgs& gn) {
    const int tid = cx.tid, wid = tid >> 6, lane = tid & 63, l31 = lane & 31, hh = lane >> 5, wm = wid >> 1, wn = wid & 1;
    f32x16 acc[2][2], tot[2][2];
#pragma unroll
    for (int a = 0; a < 2; ++a)
#pragma unroll
        for (int b = 0; b < 2; ++b)
#pragma unroll
            for (int r = 0; r < 16; ++r) { acc[a][b][r] = 0.f; tot[a][b][r] = 0.f; }
    float rs[2][16]; float bcol[2]; float sraw = 0.f;
    if (EPI == E_IN || EPI == E_GU) {
        if (tid < 128) sraw = ((const float*)(p.ws + OFF_ssq))[(size_t)(g.layer * 2 + (EPI == E_GU ? 1 : 0)) * NTOK + g.row0 + tid];
        const float* bp = ((float*)(p.ws + OFF_bias)) + (size_t)(g.layer * 3 + condrow(g.row0)) * NBIAS + (EPI == E_GU ? NIN : 0) + g.col0 + wn * 64 + l31;
        bcol[0] = bp[0]; bcol[1] = bp[32];
    }
    const int nk = g.K >> 5;
    const int lrow = wid * 32 + (lane >> 2);
    const int lsw = (lane & 3) ^ ((lane >> 4) & 3);
    const int lr0 = (g.aux & 16) ? 0 : g.row0, lc0 = (g.aux & 16) ? 0 : g.col0;
    const int ars = g.atk ? 32 : g.lda;
    const size_t aks = g.atk ? 4096 : 32;
    const bf16_t* Ag = g.A + (g.atk ? ((size_t)(lr0 >> 7) * g.atk) * 4096 : (size_t)lr0 * g.lda) + (size_t)lrow * ars + lsw * 8;
    const bf16_t* Bg = g.Bt + ((size_t)(g.col0 >> 7) * (g.K >> 5)) * 4096 + lrow * 32 + lsw * 8;
    const size_t a16 = (size_t)16 * g.lda, b16 = (size_t)16 * g.ldb;
    unsigned char* lbase = smem + wid * 2048;
    auto issue = [&](int kt, int buf) {
        unsigned char* d = lbase + buf * STG_B;
        __builtin_amdgcn_global_load_lds((const unsigned*)(Ag + kt * aks), (unsigned*)d, 16, 0, 0);
        __builtin_amdgcn_global_load_lds((const unsigned*)(Ag + 16 * ars + kt * aks), (unsigned*)(d + 1024), 16, 0, 0);
        __builtin_amdgcn_global_load_lds((const unsigned*)(Bg + (size_t)kt * 4096), (unsigned*)(d + 8192), 16, 0, 0);
        __builtin_amdgcn_global_load_lds((const unsigned*)(Bg + (size_t)kt * 4096 + 512), (unsigned*)(d + 8192 + 1024), 16, 0, 0);
    };
    const int sw = (l31 >> 2) & 3;
    const int offA = (wm * 64 + l31) * 64, offB = 8192 + (wn * 64 + l31) * 64;
    const int c0 = ((0 + hh) ^ sw) * 16, c1 = ((2 + hh) ^ sw) * 16;
    if (!pre) { issue(0, 0); issue(1, 1); issue(2, 2); }
    for (int kt0 = 0; kt0 < nk; kt0 += 4) {
#pragma unroll
        for (int u = 0; u < 4; ++u) {
            const int kt = kt0 + u;
            if (pre && kt == 0) GL_WAIT(0);
            else if (kt + 2 < nk) GL_WAIT(8); else if (kt + 1 < nk) GL_WAIT(4); else GL_WAIT(0);
            GL_BAR();
            const unsigned char* sb = smem + u * STG_B;
            const bf16x8 a00 = *(const bf16x8*)(sb + offA + c0), a10 = *(const bf16x8*)(sb + offA + 2048 + c0);
            const bf16x8 b00 = *(const bf16x8*)(sb + offB + c0), b10 = *(const bf16x8*)(sb + offB + 2048 + c0);
            const bf16x8 a01 = *(const bf16x8*)(sb + offA + c1), a11 = *(const bf16x8*)(sb + offA + 2048 + c1);
            const bf16x8 b01 = *(const bf16x8*)(sb + offB + c1), b11 = *(const bf16x8*)(sb + offB + 2048 + c1);
            __builtin_amdgcn_sched_barrier(0);
            if (kt + 3 < nk) issue(kt + 3, (u + 3) & 3);
            __builtin_amdgcn_sched_barrier(0);
            acc[0][0] = __builtin_amdgcn_mfma_f32_32x32x16_bf16(a00, b00, acc[0][0], 0, 0, 0);
            acc[0][1] = __builtin_amdgcn_mfma_f32_32x32x16_bf16(a00, b10, acc[0][1], 0, 0, 0);
            acc[1][0] = __builtin_amdgcn_mfma_f32_32x32x16_bf16(a10, b00, acc[1][0], 0, 0, 0);
            acc[1][1] = __builtin_amdgcn_mfma_f32_32x32x16_bf16(a10, b10, acc[1][1], 0, 0, 0);
            acc[0][0] = __builtin_amdgcn_mfma_f32_32x32x16_bf16(a01, b01, acc[0][0], 0, 0, 0);
            acc[0][1] = __builtin_amdgcn_mfma_f32_32x32x16_bf16(a01, b11, acc[0][1], 0, 0, 0);
            acc[1][0] = __builtin_amdgcn_mfma_f32_32x32x16_bf16(a11, b01, acc[1][0], 0, 0, 0);
            acc[1][1] = __builtin_amdgcn_mfma_f32_32x32x16_bf16(a11, b11, acc[1][1], 0, 0, 0);
        }
        if (EPI == E_BR && (kt0 & 15) == 12) {
            const int kbr = kt0 >> 4;
            const bf16_t* gp = ((bf16_t*)(p.ws + OFF_gates)) + (size_t)(((g.row0 >> 7) * 4 + kbr) * 8 + (g.col0 >> 7)) * 16384 + tid * 8;
#pragma unroll
            for (int mi = 0; mi < 2; ++mi) {
                u32x4 gw[4];
#pragma unroll
                for (int q = 0; q < 4; ++q) gw[q] = __builtin_nontemporal_load((const u32x4*)(gp + (mi * 4 + q) * 2048));
#pragma unroll
                for (int ni = 0; ni < 2; ++ni)
#pragma unroll
                    for (int r = 0; r < 16; ++r) {
                        const unsigned w = gw[ni * 2 + (r >> 3)][(r & 7) >> 1];
                        const float gv = (r & 1) ? __uint_as_float(w & 0xffff0000u) : __uint_as_float(w << 16);
                        tot[mi][ni][r] += gv * acc[mi][ni][r]; acc[mi][ni][r] = 0.f;
                    }
            }
        }
    }
    if ((EPI == E_IN || EPI == E_GU) && tid < 128)
        ((float*)(smem + 69632))[tid] = rsqrtf((float)__float_as_uint(sraw) * (SSQ_INV / DM) + 1e-6f);
    GL_BAR();
    if (hn) {
        const bf16_t* An = gn.A + (gn.atk ? ((size_t)(gn.row0 >> 7) * gn.atk) * 4096 : (size_t)gn.row0 * gn.lda) + (size_t)lrow * ars + lsw * 8;
        const bf16_t* Bn = gn.Bt + ((size_t)(gn.col0 >> 7) * (gn.K >> 5)) * 4096 + lrow * 32 + lsw * 8;
#pragma unroll
        for (int st = 0; st < 3; ++st) {
            unsigned char* d = lbase + st * STG_B;
            __builtin_amdgcn_global_load_lds((const unsigned*)(An + st * aks), (unsigned*)d, 16, 0, 0);
            __builtin_amdgcn_global_load_lds((const unsigned*)(An + 16 * ars + st * aks), (unsigned*)(d + 1024), 16, 0, 0);
            __builtin_amdgcn_global_load_lds((const unsigned*)(Bn + (size_t)st * 4096), (unsigned*)(d + 8192), 16, 0, 0);
            __builtin_amdgcn_global_load_lds((const unsigned*)(Bn + (size_t)st * 4096 + 512), (unsigned*)(d + 8192 + 1024), 16, 0, 0);
        }
    }
    if (EPI == E_IN || EPI == E_GU) {
#pragma unroll
        for (int mi = 0; mi < 2; ++mi)
#pragma unroll
            for (int r4 = 0; r4 < 4; ++r4) {
                const f32x4 q4 = *(const f32x4*)((const float*)(smem + 69632) + wm * 64 + mi * 32 + 8 * r4 + 4 * hh);
                rs[mi][4 * r4 + 0] = q4[0]; rs[mi][4 * r4 + 1] = q4[1]; rs[mi][4 * r4 + 2] = q4[2]; rs[mi][4 * r4 + 3] = q4[3];
            }
        bcol[0] = (float)__float_as_int(bcol[0]) * BIAS_INV; bcol[1] = (float)__float_as_int(bcol[1]) * BIAS_INV;
    }
    if (EPI == E_IN && g.col0 >= NPR) {
        const int gc = g.col0 - NPR;
        bf16_t* gp = ((bf16_t*)(p.ws + OFF_gates)) + (size_t)(((g.row0 >> 7) * 4 + (gc >> 10)) * 8 + ((gc & 1023) >> 7)) * 16384 + tid * 8;
#pragma unroll
        for (int mi = 0; mi < 2; ++mi)
#pragma unroll
            for (int ni = 0; ni < 2; ++ni) {
                float sg[16]; f32x16 xv;
#pragma unroll
                for (int r = 0; r < 16; ++r) xv[r] = acc[mi][ni][r] * rs[mi][r] + bcol[ni];
                sigmoid16(xv, sg);
                *(u32x4*)(gp + ((mi * 2 + ni) * 2) * 2048) = (u32x4){pack2(sg[0], sg[1]), pack2(sg[2], sg[3]), pack2(sg[4], sg[5]), pack2(sg[6], sg[7])};
                *(u32x4*)(gp + ((mi * 2 + ni) * 2 + 1) * 2048) = (u32x4){pack2(sg[8], sg[9]), pack2(sg[10], sg[11]), pack2(sg[12], sg[13]), pack2(sg[14], sg[15])};
            }
        return;
    }
    if (EPI == E_IN || EPI == E_GU || EPI == E_BR) {
        constexpr int OW = (EPI == E_GU) ? 64 : 128;
        constexpr int OS = OW + 8;
        constexpr int NH = (EPI == E_GU) ? 1 : 2;
        constexpr int RH = 128 / NH;
        constexpr int CPR = OW / 8;
        constexpr int OLD = (EPI == E_GU) ? DFF : (EPI == E_BR) ? DM : NPR;
        bf16_t* T = (bf16_t*)(smem + 3 * STG_B);
        bf16_t* O = (EPI == E_GU) ? ((bf16_t*)(p.ws + OFF_act)) + (size_t)g.row0 * DFF + (g.col0 >> 1)
                  : (EPI == E_BR) ? ((bf16_t*)(p.ws + OFF_merged)) + (size_t)g.row0 * DM + g.col0
                                  : ((bf16_t*)(p.ws + OFF_P)) + (size_t)g.row0 * NPR + g.col0;
#pragma unroll
        for (int hf = 0; hf < NH; ++hf) {
            if (NH == 1 || wm == hf) {
#pragma unroll
                for (int mi = 0; mi < 2; ++mi) {
                    float sg[16];
                    if (EPI == E_GU) {
                        f32x16 av;
#pragma unroll
                        for (int r = 0; r < 16; ++r) av[r] = acc[mi][0][r] * rs[mi][r] + bcol[0];
                        sigmoid16(av, sg);
#pragma unroll
                        for (int r = 0; r < 16; ++r) sg[r] = av[r] * sg[r] * (acc[mi][1][r] * rs[mi][r] + bcol[1]);
                    }
#pragma unroll
                    for (int r = 0; r < 16; ++r) {
                        const int rl = (NH == 1 ? wm * 64 : 0) + mi * 32 + (r & 3) + 8 * (r >> 2) + 4 * hh;
                        if (EPI == E_GU) {
                            T[rl * OS + wn * 32 + l31] = f2bf(sg[r]);
                        } else if (EPI == E_BR) {
                            T[rl * OS + wn * 64 + l31] = f2bf(tot[mi][0][r]);
                            T[rl * OS + wn * 64 + 32 + l31] = f2bf(tot[mi][1][r]);
                        } else {
                            T[rl * OS + wn * 64 + l31] = f2bf(acc[mi][0][r] * rs[mi][r] + bcol[0]);
                            T[rl * OS + wn * 64 + 32 + l31] = f2bf(acc[mi][1][r] * rs[mi][r] + bcol[1]);
                        }
                    }
                }
            }
            GL_BAR();
#pragma unroll
            for (int i = 0; i < (RH * CPR) / 256; ++i) {
                const int ch = tid + 256 * i; const int rr = ch / CPR, cc = ch % CPR;
                bf16_t* od;
                if (EPI == E_GU) od = ((bf16_t*)(p.ws + OFF_act)) + wtile_off(g.row0 + hf * RH + rr, (g.col0 >> 1) + cc * 8, DFF);
                else if (EPI == E_BR) od = ((bf16_t*)(p.ws + OFF_merged)) + wtile_off(g.row0 + hf * RH + rr, g.col0 + cc * 8, DM);
                else od = O + (size_t)(hf * RH + rr) * OLD + cc * 8;
                *(u32x4*)od = *(const u32x4*)(T + rr * OS + cc * 8);
            }
            GL_BAR();
        }
        return;
    }
    if (EPI == E_RES) {
        const int cr = condrow(g.row0), which = g.aux & 7;
        const bool mk = (which == 2) || (g.layer + 1 < NL);
        const int nl = which == 2 ? g.layer : g.layer + 1;
        const float* modc = ((float*)(p.ws + OFF_mod)) + (size_t)(g.layer * 3 + cr) * 6144 + which * DM;
        float gm[2];
        gm[0] = modc[g.col0 + wn * 64 + l31]; gm[1] = modc[g.col0 + wn * 64 + 32 + l31];
        const int cq = tid & 31;
        f32x4 gn4 = (f32x4){0.f, 0.f, 0.f, 0.f};
        if (mk) {
            const f32x4 gg = *(const f32x4*)((which == 2 ? p.g_ffn : p.g_mix) + nl * DM + g.col0 + cq * 4);
            const f32x4 sc = *(const f32x4*)(((float*)(p.ws + OFF_mod)) + (size_t)(nl * 3 + cr) * 6144 + (which == 2 ? 4 : 1) * DM + g.col0 + cq * 4);
            gn4 = gg * (1.f + sc);
        }
        unsigned* ssq = ((unsigned*)(p.ws + OFF_ssq)) + (size_t)(nl * 2 + (which == 2 ? 1 : 0)) * NTOK;
        float* Dl = (float*)smem;
#pragma unroll
        for (int mi = 0; mi < 2; ++mi) {
            f32x4 xo[8];
#pragma unroll
            for (int i = 0; i < 8; ++i) {
                const int rr = (tid >> 5) + 8 * i;
                xo[i] = *(const f32x4*)((const float*)(p.out) + (size_t)(g.row0 + (rr >> 5) * 64 + mi * 32 + (rr & 31)) * DM + g.col0 + cq * 4);
            }
#pragma unroll
            for (int r = 0; r < 16; ++r) {
                const int rl = wm * 32 + (r & 3) + 8 * (r >> 2) + 4 * hh;
                Dl[rl * 132 + wn * 64 + l31] = gm[0] * acc[mi][0][r];
                Dl[rl * 132 + wn * 64 + 32 + l31] = gm[1] * acc[mi][1][r];
            }
            GL_BAR();
#pragma unroll
            for (int i = 0; i < 8; ++i) {
                const int rr = (tid >> 5) + 8 * i;
                const int row = g.row0 + (rr >> 5) * 64 + mi * 32 + (rr & 31);
                const f32x4 xn = xo[i] + *(const f32x4*)(Dl + rr * 132 + cq * 4);
                *(f32x4*)((float*)(p.out) + (size_t)row * DM + g.col0 + cq * 4) = xn;
                if (mk) {
                    const f32x4 hv = xn * gn4;
                    *(u32x2*)(((bf16_t*)(p.ws + OFF_h)) + wtile_off(row, g.col0 + cq * 4, DM)) = (u32x2){pack2(hv[0], hv[1]), pack2(hv[2], hv[3])};
                    float sq = xn[0] * xn[0] + xn[1] * xn[1] + xn[2] * xn[2] + xn[3] * xn[3];
#pragma unroll
                    for (int o2 = 16; o2 >= 1; o2 >>= 1) sq += __shfl_xor(sq, o2);
                    if (cq == 0) atomicAdd(ssq + row, (unsigned)(sq * SSQ_SCALE + 0.5f));
                }
            }
            GL_BAR();
        }
        return;
    }
#pragma unroll
    for (int mi = 0; mi < 2; ++mi)
#pragma unroll
        for (int r = 0; r < 16; ++r) {
            const int row = g.row0 + wm * 64 + mi * 32 + (r & 3) + 8 * (r >> 2) + 4 * hh;
            if (EPI == E_GU) {
                const float a = acc[mi][0][r], b = acc[mi][1][r];
                const int ac = ((g.col0 + wn * 64) >> 1) + l31;
                ((bf16_t*)(p.ws + OFF_act))[(size_t)row * DFF + ac] = f2bf(a / (1.f + __expf(-a)) * b);
            } else {
#pragma unroll
                for (int ni = 0; ni < 2; ++ni) {
                    const int col = g.col0 + wn * 64 + ni * 32 + l31;
                    const float v = acc[mi][ni][r];
                    if (EPI == E_IN) {
                        ((float*)(p.ws + OFF_P))[(size_t)row * NPR + col] = v;
                    } else if (EPI == E_BR) {
                        ((bf16_t*)(p.ws + OFF_merged))[(size_t)row * DM + col] = f2bf(tot[mi][ni][r]);
                    } else if (EPI == E_RES) {
                        const float gm = ((float*)(p.ws + OFF_mod))[(size_t)(g.layer * 3 + condrow(row)) * 6144 + (g.aux & 7) * DM + col];
                        __attribute__((address_space(1))) float* o = p.out + (size_t)row * DM + col;
                        if (!(g.aux & 8)) *o = *o + gm * v;
                    } else if (EPI == E_POOL) {
                        ((bf16_t*)(p.ws + OFF_br))[wtile_off(row, 1536 + g.aux * 128 + col, 2048)] = f2bf(v * p.pool_scale[g.layer * 512 + g.aux * 128 + col]);
                    }
                }
            }
        }
}

template <int EPI> DI void gemm_phase(const Ctx& cx, const Params& p, int layer, const bf16_t* A, int lda, const bf16_t* Bt, int ldb, int K, int N, int aux, unsigned char* smem) {
    const int nM = NTOK / 128, nN = N / 128;
    const int x = cx.bid & 7, j = cx.bid >> 3, J = gridDim.x >> 3;
    GemmArgs g; g.A = A; g.lda = lda; g.Bt = Bt; g.ldb = ldb; g.K = K; g.layer = layer; g.aux = aux; g.atk = K >> 5;
    if (nN == 8) {
        for (int t = j; t < (nM / 8) * 8; t += J) {
            g.row0 = ((t >> 3) * 8 + x) * 128; g.col0 = (t & 7) * 128;
            gemm_tile<EPI>(cx, p, g, smem, false, false, g);
        }
        return;
    }
    const int SN = J >> 3;
    const int nSM = nM / 8, nSN = (nN + SN - 1) / SN;
    GemmArgs gnx = g;
    int st = x; bool have = false;
    for (; st < nSM * nSN; st += 8) { const int pn = (st / nSM) * SN + (j >> 3); if (pn < nN) { g.row0 = ((st % nSM) * 8 + (j & 7)) * 128; g.col0 = pn * 128; have = true; st += 8; break; } }
    bool pre = false;
    while (have) {
        bool hn = false;
        for (; st < nSM * nSN; st += 8) { const int pn = (st / nSM) * SN + (j >> 3); if (pn < nN) { gnx.row0 = ((st % nSM) * 8 + (j & 7)) * 128; gnx.col0 = pn * 128; hn = true; st += 8; break; } }
        gemm_tile<EPI>(cx, p, g, smem, pre, hn, gnx);
        pre = hn; have = hn; g.row0 = gnx.row0; g.col0 = gnx.col0;
    }
}

DI void post_vunit(const Ctx& cx, const Params& p, int layer, int vt) {
    const int tid = cx.tid; const int pc = tid & 63, which = (tid >> 6) & 1, th = tid >> 7, col = 2 * pc;
    const int r0 = vt * 64 + th * 32;
    const bf16_t* src = ((bf16_t*)(p.ws + OFF_P)) + (size_t)r0 * NPR + (which ? 1408 : 640) + col;
    bf16_t* dst; size_t dstride; __attribute__((address_space(1))) float* of = nullptr;
    if (r0 < NCTX) { const int b = r0 >> 8, t0 = r0 & 255;
        dst = (which ? ((bf16_t*)(p.ws + OFF_vCcT)) : ((bf16_t*)(p.ws + OFF_vAcT))) + ((size_t)(b * 128 + col)) * 256 + t0; dstride = 256;
        of = p.out + (which ? OUT_VW : OUT_VA) + ((size_t)((b * 4 + layer) * 256 + t0)) * 128 + col;
    } else { const int b = (r0 - NCTX) >> 10, t0 = (r0 - NCTX) & 1023;
        dst = (which ? ((bf16_t*)(p.ws + OFF_vClT)) : ((bf16_t*)(p.ws + OFF_vAlT))) + ((size_t)((layer * 2 + b) * 128 + col)) * 1536 + 512 + t0; dstride = 1536;
    }
    unsigned raw[32];
#pragma unroll
    for (int j = 0; j < 32; ++j) raw[j] = *(const unsigned*)(src + (size_t)j * NPR);
    __builtin_amdgcn_sched_barrier(0);
    if (of) {
#pragma unroll
        for (int j = 0; j < 32; ++j) {
            typedef float f32x2 __attribute__((ext_vector_type(2)));
            __builtin_nontemporal_store((f32x2){__uint_as_float(raw[j] << 16), __uint_as_float(raw[j] & 0xffff0000u)}, (__attribute__((address_space(1))) f32x2*)(of + (size_t)j * 128));
        }
    }
#pragma unroll
    for (int jc = 0; jc < 4; ++jc) {
        unsigned lo[4], hi[4];
#pragma unroll
        for (int q = 0; q < 4; ++q) {
            const unsigned a = raw[jc * 8 + 2 * q], b2 = raw[jc * 8 + 2 * q + 1];
            lo[q] = (a & 0xffffu) | (b2 << 16);
            hi[q] = (a >> 16) | (b2 & 0xffff0000u);
        }
        *(u32x4*)(dst + jc * 8) = (u32x4){lo[0], lo[1], lo[2], lo[3]};
        *(u32x4*)(dst + dstride + jc * 8) = (u32x4){hi[0], hi[1], hi[2], hi[3]};
    }
}

DI void post_row(const Ctx& cx, const Params& p, int layer, int r) {
    const int lane = cx.tid & 63;
    const bf16_t* Pr = ((bf16_t*)(p.ws + OFF_P)) + (size_t)r * NPR;
    const bool lat = r >= NCTX;
    int b, t, T;
    if (lat) { b = (r - NCTX) >> 10; t = (r - NCTX) & 1023; T = 1024; } else { b = r >> 8; t = r & 255; T = 256; }
    const int lh = lane & 31;
    unsigned hraw[10];
#pragma unroll
    for (int hp = 0; hp < 10; ++hp) {
        const int col = hp < 4 ? hp * 128 : hp == 4 ? 512 : hp < 9 ? 768 + (hp - 5) * 128 : 1280;
        hraw[hp] = __builtin_nontemporal_load((const unsigned*)(Pr + col + 2 * lane));
    }
    float cs[2] = {1.f, 1.f}, sn[2] = {0.f, 0.f};
    if (lat) {
        const float* rp = (float*)(p.ws + OFF_rope);
        const int pos = (lh < 16) ? (t >> 6) : (t & 63); const int i0 = (2 * lh) & 15;
        cs[0] = rp[pos * 16 + i0]; cs[1] = rp[pos * 16 + i0 + 1]; sn[0] = rp[1024 + pos * 16 + i0]; sn[1] = rp[1024 + pos * 16 + i0 + 1];
        if (!(lh & 8)) { sn[0] = -sn[0]; sn[1] = -sn[1]; }
    }
    float gsel4[4][2];
    gsel4[0][0] = p.gq_a[layer * 64 + 2 * lh]; gsel4[0][1] = p.gq_a[layer * 64 + 2 * lh + 1];
    gsel4[1][0] = p.gk_a[layer * 64 + 2 * lh]; gsel4[1][1] = p.gk_a[layer * 64 + 2 * lh + 1];
    gsel4[2][0] = p.gq_c[layer * 64 + 2 * lh]; gsel4[2][1] = p.gq_c[layer * 64 + 2 * lh + 1];
    gsel4[3][0] = p.gk_c[layer * 64 + 2 * lh]; gsel4[3][1] = p.gk_c[layer * 64 + 2 * lh + 1];
#pragma unroll
    for (int hp = 0; hp < 10; ++hp) {
        const int typ = hp < 4 ? 0 : hp == 4 ? 1 : hp < 9 ? 2 : 3;
        const bool isk = typ & 1; const int which = typ >> 1;
        const float v0 = __uint_as_float(hraw[hp] << 16), v1 = __uint_as_float(hraw[hp] & 0xffff0000u);
        float ss = v0 * v0 + v1 * v1;
#pragma unroll
        for (int o = 16; o >= 1; o >>= 1) ss += __shfl_xor(ss, o);
        const float rn = rsqrtf(ss * (1.0f / 64.f) + 1e-6f);
        float y0 = v0 * rn * gsel4[typ][0], y1 = v1 * rn * gsel4[typ][1];
        if (lat) { const float p0 = __shfl_xor(y0, 8), p1 = __shfl_xor(y1, 8); y0 = y0 * cs[0] + p0 * sn[0]; y1 = y1 * cs[1] + p1 * sn[1]; }
        if (!isk) {
            const int qh0 = (which ? hp - 5 : hp) * 2;
            *(unsigned*)(((bf16_t*)(p.ws + (which ? OFF_qC : OFF_qA))) + (size_t)r * 512 + qh0 * 64 + 2 * lane) = pack2(y0 * QSCALE, y1 * QSCALE);
        } else if (!lat) {
            *(unsigned*)(((bf16_t*)(p.ws + (which ? OFF_kCc : OFF_kAc))) + (size_t)r * 128 + 2 * lane) = pack2(y0, y1);
            __attribute__((address_space(1))) float* ok = p.out + (which ? OUT_KW : OUT_KA) + ((size_t)((b * 4 + layer) * 256 + t)) * 128 + 2 * lane;
            __builtin_nontemporal_store(y0, ok); __builtin_nontemporal_store(y1, ok + 1);
        } else {
            *(unsigned*)(((bf16_t*)(p.ws + (which ? OFF_kCl : OFF_kAl))) + ((size_t)((layer * 2 + b) * 1536 + 512 + t)) * 128 + 2 * lane) = pack2(y0, y1);
        }
    }
    asm volatile("" ::: "memory");
    const float mm = (t > 0) ? 1.f : 0.f, mp = (t < T - 1) ? 1.f : 0.f;
    const bf16_t* Pm = Pr - ((t > 0) ? NPR : 0);
    const bf16_t* Pp = Pr + ((t < T - 1) ? NPR : 0);
    const float* cw = p.conv_w + layer * 3 * 512;
#pragma unroll
    for (int half = 0; half < 2; ++half) {
        float yc[2][2], ym[2][2];
#pragma unroll
        for (int ii = 0; ii < 2; ++ii) {
            const int i = half * 2 + ii;
            const int c = i * 128 + 2 * lane;
            const unsigned gc0 = *(const unsigned*)(Pr + 2560 + c), u0 = *(const unsigned*)(Pr + 1536 + c);
            const unsigned gcm = *(const unsigned*)(Pm + 2560 + c), um = *(const unsigned*)(Pm + 1536 + c);
            const unsigned gcp = *(const unsigned*)(Pp + 2560 + c), up = *(const unsigned*)(Pp + 1536 + c);
            const unsigned gb = __builtin_nontemporal_load((const unsigned*)(Pr + 2048 + c));
            const float w0[2] = {cw[c], cw[c + 1]}, w1[2] = {cw[512 + c], cw[512 + c + 1]}, w2[2] = {cw[1024 + c], cw[1024 + c + 1]};
            const int hw = 1 << i;
            int lo = t - hw; lo = lo < 0 ? 0 : lo;
            int hi = t + hw; hi = hi > T ? T : hi;
            float sacc[2] = {0.f, 0.f}; unsigned pf = 0u;
#pragma unroll
            for (int q = -hw; q < hw; ++q) {
                const int tq = t + q; const bool ok = tq >= 0 && tq < T;
                const int dq = ok ? q : 0;
                const unsigned w = *(const unsigned*)(Pr + (ptrdiff_t)dq * NPR + 3072 + c);
                const float okf = ok ? 1.f : 0.f;
                sacc[0] += __uint_as_float(w << 16) * okf; sacc[1] += __uint_as_float(w & 0xffff0000u) * okf;
                if (q == 0) pf = w;
            }
            const float rn = 1.0f / (float)(hi - lo);
#pragma unroll
            for (int e = 0; e < 2; ++e) {
                auto sel = [&](unsigned w) { return e ? __uint_as_float(w & 0xffff0000u) : __uint_as_float(w << 16); };
                const float z0 = sel(gc0) * sel(u0), zm = sel(gcm) * sel(um) * mm, zp = sel(gcp) * sel(up) * mp;
                yc[ii][e] = sel(gb) * (zm * w0[e] + z0 * w1[e] + zp * w2[e]);
                ym[ii][e] = sacc[e] * rn - sel(pf);
            }
        }
#pragma unroll
        for (int ii = 0; ii < 2; ++ii) {
            const int c = (half * 2 + ii) * 128 + 2 * lane;
            *(unsigned*)(((bf16_t*)(p.ws + OFF_br)) + wtile_off(r, 512 + c, 2048)) = pack2(yc[ii][0], yc[ii][1]);
            *(unsigned*)(((bf16_t*)(p.ws + OFF_ypool)) + (size_t)r * 512 + c) = pack2(ym[ii][0], ym[ii][1]);
        }
        asm volatile("" ::: "memory");
    }
}

constexpr int KSTR = 72, VSTR = 68;
constexpr int ATT_BUF_E = 64 * KSTR + 64 * VSTR;
DI void attn_unit(const Ctx& cx, const Params& p, int layer, int kind, int b, int head, int qb, unsigned char* smem) {
    const int tid = cx.tid, wid = tid >> 6, lane = tid & 63, ql = lane & 31, hh = lane >> 5;
    const bool isC = kind & 1, isLat = kind >= 2;
    const int kvh = head >> 2;
    const int qrow = (isLat ? NCTX + b * 1024 : b * 256) + qb * 128 + wid * 32 + ql;
    const bf16_t* Kp; const bf16_t* Vt; int S;
    if (!isLat) { S = 256; Kp = (isC ? ((bf16_t*)(p.ws + OFF_kCc)) : ((bf16_t*)(p.ws + OFF_kAc))) + (size_t)b * 256 * 128 + kvh * 64; Vt = (isC ? ((bf16_t*)(p.ws + OFF_vCcT)) : ((bf16_t*)(p.ws + OFF_vAcT))) + (size_t)((b * 2 + kvh) * 64) * 256; }
    else { S = 1536; Kp = (isC ? ((bf16_t*)(p.ws + OFF_kCl)) : ((bf16_t*)(p.ws + OFF_kAl))) + (size_t)((layer * 2 + b) * 1536) * 128 + kvh * 64; Vt = (isC ? ((bf16_t*)(p.ws + OFF_vClT)) : ((bf16_t*)(p.ws + OFF_vAlT))) + (size_t)(((layer * 2 + b) * 2 + kvh) * 64) * 1536; }
    int nt1 = S / 64, t2lo = 0, t2hi = 0;
    if (kind == 3) { nt1 = 8; const int i0 = qb * 128; const int jlo = i0 - 128 < 0 ? 0 : i0 - 128; const int jhi = i0 + 256 > 1024 ? 1024 : i0 + 256; t2lo = 8 + (jlo >> 6); t2hi = 8 + (jhi >> 6); }
    const int ntiles = nt1 + (t2hi - t2lo);
    bf16x8 qf[4];
    { const bf16_t* q = (isC ? ((bf16_t*)(p.ws + OFF_qC)) : ((bf16_t*)(p.ws + OFF_qA))) + (size_t)qrow * 512 + head * 64 + hh * 8;
#pragma unroll
      for (int ks = 0; ks < 4; ++ks) qf[ks] = *(const bf16x8*)(q + ks * 16); }
    bf16_t* L = (bf16_t*)smem;
    const int sr = tid >> 3, scc = (tid & 7) * 8;
    u32x4 rk[2], rv[2];
    auto gload = [&](int it) {
        const int kt = it < nt1 ? it : t2lo + (it - nt1);
#pragma unroll
        for (int i = 0; i < 2; ++i) {
            rk[i] = *(const u32x4*)(Kp + (size_t)(kt * 64 + sr + 32 * i) * 128 + scc);
            rv[i] = *(const u32x4*)(Vt + (size_t)(sr + 32 * i) * S + kt * 64 + scc);
        }
    };
    auto lstore = [&](int buf) {
        bf16_t* Ks = L + buf * ATT_BUF_E; bf16_t* Vs = Ks + 64 * KSTR;
#pragma unroll
        for (int i = 0; i < 2; ++i) {
            *(u32x4*)(Ks + (sr + 32 * i) * KSTR + scc) = rk[i];
            u32x2* vd = (u32x2*)(Vs + (sr + 32 * i) * VSTR + scc);
            vd[0] = (u32x2){rv[i][0], rv[i][1]}; vd[1] = (u32x2){rv[i][2], rv[i][3]};
        }
    };
    f32x16 ot[2];
#pragma unroll
    for (int r = 0; r < 16; ++r) { ot[0][r] = 0.f; ot[1][r] = 0.f; }
    float m = -1e30f, lsum = 0.f;
    const int qpos = qb * 128 + wid * 32 + ql;
    gload(0); lstore(0); __syncthreads();
    for (int it = 0; it < ntiles; ++it) {
        const int buf = it & 1;
        if (it + 1 < ntiles) gload(it + 1);
        const bf16_t* Ks = L + buf * ATT_BUF_E; const bf16_t* Vs = Ks + 64 * KSTR;
        f32x16 st[2];
#pragma unroll
        for (int j = 0; j < 2; ++j) {
#pragma unroll
            for (int r = 0; r < 16; ++r) st[j][r] = 0.f;
#pragma unroll
            for (int ks = 0; ks < 4; ++ks) {
                const bf16x8 a = *(const bf16x8*)(Ks + (j * 32 + ql) * KSTR + ks * 16 + hh * 8);
                st[j] = __builtin_amdgcn_mfma_f32_32x32x16_bf16(a, qf[ks], st[j], 0, 0, 0);
            }
        }
        if (kind == 3 && it >= nt1) {
            const int kt = t2lo + (it - nt1);
            const int jbase = kt * 64 - 512;
#pragma unroll
            for (int j = 0; j < 2; ++j)
#pragma unroll
                for (int r = 0; r < 16; ++r) {
                    const int jp = jbase + j * 32 + (r & 3) + 8 * (r >> 2) + 4 * hh;
                    const int d = qpos - jp;
                    if (d > 128 || d < -128) st[j][r] = -1e30f;
                }
        }
        float mx = st[0][0];
#pragma unroll
        for (int j = 0; j < 2; ++j)
#pragma unroll
            for (int r = 0; r < 16; ++r) mx = fmaxf(mx, st[j][r]);
        mx = fmaxf(mx, __shfl_xor(mx, 32));
        const float mn = fmaxf(m, mx);
        const float alpha = __builtin_amdgcn_exp2f(m - mn);
        m = mn;
        float ps = 0.f;
#pragma unroll
        for (int j = 0; j < 2; ++j)
#pragma unroll
            for (int r = 0; r < 16; ++r) { const float e = __builtin_amdgcn_exp2f(st[j][r] - mn); st[j][r] = e; ps += e; }
        lsum = lsum * alpha + ps;
#pragma unroll
        for (int r = 0; r < 16; ++r) { ot[0][r] *= alpha; ot[1][r] *= alpha; }
#pragma unroll
        for (int j = 0; j < 2; ++j)
#pragma unroll
            for (int s2 = 0; s2 < 2; ++s2) {
                const u32x4 pw = (u32x4){pack2(st[j][8 * s2 + 0], st[j][8 * s2 + 1]), pack2(st[j][8 * s2 + 2], st[j][8 * s2 + 3]),
                                         pack2(st[j][8 * s2 + 4], st[j][8 * s2 + 5]), pack2(st[j][8 * s2 + 6], st[j][8 * s2 + 7])};
                const bf16x8 pf = __builtin_bit_cast(bf16x8, pw);
#pragma unroll
                for (int db = 0; db < 2; ++db) {
                    const bf16_t* vp = Vs + (db * 32 + ql) * VSTR + j * 32 + s2 * 16 + 4 * hh;
                    const s16x4 lo = *(const s16x4*)vp, hi = *(const s16x4*)(vp + 8);
                    const bf16x8 vf = __builtin_shufflevector(lo, hi, 0, 1, 2, 3, 4, 5, 6, 7);
                    ot[db] = __builtin_amdgcn_mfma_f32_32x32x16_bf16(vf, pf, ot[db], 0, 0, 0);
                }
            }
        if (it + 1 < ntiles) lstore(buf ^ 1);
        __syncthreads();
    }
    float lt = lsum + __shfl_xor(lsum, 32);
    float oscale = 1.f;
    if (isC) {
        const float sk = p.sink[layer * 8 + head] * LOG2E;
        const float mf = fmaxf(m, sk);
        oscale = __builtin_amdgcn_exp2f(m - mf);
        lt = lt * oscale + __builtin_amdgcn_exp2f(sk - mf);
    }
    const float inv = oscale / lt;
    bf16_t* o = ((bf16_t*)(p.ws + OFF_br)) + wtile_off(qrow, (isC ? 1024 : 0) + head * 64, 2048);
#pragma unroll
    for (int db = 0; db < 2; ++db)
#pragma unroll
        for (int g4 = 0; g4 < 4; ++g4) {
            const int d = db * 32 + 8 * g4 + 4 * hh;
            *(u32x2*)(o + db * 4096 + 8 * g4 + 4 * hh) = (u32x2){pack2(ot[db][4 * g4 + 0] * inv, ot[db][4 * g4 + 1] * inv), pack2(ot[db][4 * g4 + 2] * inv, ot[db][4 * g4 + 3] * inv)};
        }
}

DI void idle_transposes(const Ctx& cx, const Params& p, int layer, int part, unsigned char* smem) {
    if (layer + 1 >= NL) return;
    const int lo = part == 1 ? 0 : part == 2 ? 1640 : 2510, hi = part == 1 ? 1640 : part == 2 ? 2510 : 4816;
    unsigned* qctr = (unsigned*)(p.ws + OFF_bar) + 3856 + (layer * 4 + part) * 8;
    volatile unsigned* slot = (volatile unsigned*)(smem + 73696);
    for (;;) {
        __syncthreads();
        if (cx.tid == 0) *slot = atomicAdd(qctr, 1u);
        __syncthreads();
        const int t = (int)*slot;
        if (t >= hi - lo) break;
        prologue_transpose(cx, p, (layer + 1) * 4816 + lo + t, smem);
    }
}

DI void run_phase(const Ctx& cx, const Params& p, int ph, unsigned char* smem, int dry) {
    const int tid = cx.tid, wid = tid >> 6;
    if (ph < 2) {
        const int total = ph == 0 ? PRO_MOD + PRO_MISC + 1488 : 3328 + 512;
        for (int u = cx.bid; u < total; u += gridDim.x) {
            int ti = -1;
            if (ph == 0) {
                if (u < PRO_MOD) prologue_mod(cx, p, u, smem);
                else if (u < PRO_MOD + PRO_MISC) prologue_misc(cx, p, u - PRO_MOD);
                else { const int i = u - PRO_MOD - PRO_MISC; ti = i < 768 ? 1920 + i : 4096 + (i - 768); }
            } else {
                if (u < 3328) ti = u < 1920 ? u : 2688 + (u - 1920);
                else x0_rows(cx, p, (u - 3328) * 4 + wid, 2048);
            }
            if (ti >= 0) prologue_transpose(cx, p, ti, smem);
        }
        return;
    }
    const int layer = (ph - 2) / 7, sub = (ph - 2) % 7;
    switch (sub) {
    case 0: gemm_phase<E_IN>(cx, p, layer, ((bf16_t*)(p.ws + OFF_h)), DM, ((bf16_t*)(p.ws + OFF_WinT)) + (size_t)layer * NIN * DM, DM, DM, NPR, 0, smem); break;
    case 1: for (int u = cx.bid; u < 96 + 1536; u += gridDim.x) { if (u < 96) post_vunit(cx, p, layer, u); else post_row(cx, p, layer, (u - 96) * 4 + wid); } break;
    case 2:
        for (int u = cx.bid; u < 960; u += gridDim.x) {
            if (u < 128) attn_unit(cx, p, layer, 2, u >> 6, (u >> 3) & 7, u & 7, smem);
            else if (u < 256) { const int v = u - 128; attn_unit(cx, p, layer, 3, v >> 6, (v >> 3) & 7, v & 7, smem); }
            else if (u < 512) { const int v = u - 256; attn_unit(cx, p, layer, 0, v >> 4, (v >> 1) & 7, v & 1, smem); }
            else if (u < 768) { const int v = u - 512; attn_unit(cx, p, layer, 1, v >> 4, (v >> 1) & 7, v & 1, smem); }
            else { const int v = u - 768; const int pm = v >> 2, grp = v & 3;
                GemmArgs g; g.A = ((bf16_t*)(p.ws + OFF_ypool)) + grp * 128; g.lda = 512; g.Bt = ((bf16_t*)(p.ws + OFF_PoolT)) + (size_t)(layer * 4 + grp) * 16384; g.ldb = 128; g.K = 128; g.row0 = pm * 128; g.col0 = 0; g.layer = layer; g.aux = grp; g.atk = 0;
                gemm_tile<E_POOL>(cx, p, g, smem, false, false, g); }
        }
        if (!dry) {
            unsigned* qctr = (unsigned*)(p.ws + OFF_bar) + 3600 + (layer * 2 + dry) * 32;
            volatile unsigned* slot = (volatile unsigned*)(smem + 73696);
            GemmArgs g, gnx; g.A = (bf16_t*)(p.ws + OFF_h); g.lda = DM; g.Bt = ((bf16_t*)(p.ws + OFF_WinT)) + (size_t)layer * NIN * DM; g.ldb = DM; g.K = DM; g.layer = layer; g.aux = 0; g.atk = DM >> 5;
            gnx = g;
            __syncthreads();
            if (tid == 0) *slot = atomicAdd(qctr, 1u);
            __syncthreads();
            unsigned t = *slot; bool pre = false;
            while (t < 1536u) {
                __syncthreads();
                if (tid == 0) *slot = atomicAdd(qctr, 1u);
                __syncthreads();
                const unsigned tn = *slot;
                g.row0 = (int)(t % 48u) * 128; g.col0 = NPR + (int)(t / 48u) * 128;
                const bool hn = tn < 1536u;
                if (hn) { gnx.row0 = (int)(tn % 48u) * 128; gnx.col0 = NPR + (int)(tn / 48u) * 128; }
                gemm_tile<E_IN>(cx, p, g, smem, pre, hn, gnx);
                pre = hn; t = tn;
            }
        }
        break;
    case 3: gemm_phase<E_BR>(cx, p, layer, ((bf16_t*)(p.ws + OFF_br)), 2048, ((bf16_t*)(p.ws + OFF_WbrT)) + (size_t)layer * DM * 2048, 2048, 2048, DM, 0, smem); break;
    case 4: gemm_phase<E_RES>(cx, p, layer, ((bf16_t*)(p.ws + OFF_merged)), DM, ((bf16_t*)(p.ws + OFF_WoT)) + (size_t)layer * DM * DM, DM, DM, DM, 2, smem); break;
    case 5: gemm_phase<E_GU>(cx, p, layer, ((bf16_t*)(p.ws + OFF_h)), DM, ((bf16_t*)(p.ws + OFF_WguT)) + (size_t)layer * 2 * DFF * DM, DM, DM, 2 * DFF, 0, smem); break;
    case 6: gemm_phase<E_RES>(cx, p, layer, ((bf16_t*)(p.ws + OFF_act)), DFF, ((bf16_t*)(p.ws + OFF_WdT)) + (size_t)layer * DM * DFF, DFF, DFF, DM, 5, smem); break;
    }
    if (sub == 3 || sub == 4 || sub == 6) idle_transposes(cx, p, layer, sub == 3 ? 1 : sub == 4 ? 2 : 3, smem);
}

__global__ void __launch_bounds__(256, 2) fwd_megakernel(Params p) {
    __shared__ __attribute__((aligned(16))) unsigned char smem[73728];
#if MK_MULTI
    Ctx cx; cx.tid = threadIdx.x; cx.bid = blockIdx.x;
    run_phase(cx, p, p.phase_lo, smem, 0);
#else
    if (threadIdx.x == 0) *(uint4*)(smem + 73712) = make_uint4(0u, 0u, 0u, 0u);
    __syncthreads();
    XcdBarrier xb = xcd_barrier_post((unsigned*)(p.ws + OFF_bar), (volatile LAS unsigned*)(smem + 73712));
    if (p.phase_lo < 0) cg::this_grid().sync();
    for (int ph = p.phase_lo; ph < p.phase_hi; ++ph) {
        Ctx cx; cx.tid = threadIdx.x; cx.bid = blockIdx.x;
        asm volatile("" : "+v"(cx.tid));
        asm volatile("" : "+s"(cx.bid));
        Params q = p;
        asm volatile("" : "+s"(q.ws));
        asm volatile("" : "+s"(q.out));
        run_phase(cx, q, ph, smem, 0);
        if (ph + 1 < p.phase_hi) xcd_barrier(xb);
#if PROBE2
        if (ph >= 2) { const int sub = (ph - 2) % 7;
            if (((PROBE2 & 1) && sub == 0) || ((PROBE2 & 2) && sub == 1) || ((PROBE2 & 8) && sub == 5)) { run_phase(cx, q, ph, smem, 0); xcd_barrier(xb); }
            if ((PROBE2 & 4) && sub == 1) { run_phase(cx, q, ph + 1, smem, 1); xcd_barrier(xb); } }
#endif
    }
#endif
}

extern "C" void kernel_launch(void* const* d_in, const int* in_sizes, int n_in, void* d_out, int out_size, void* d_ws, size_t ws_size, hipStream_t stream) {
    Params p; memset(&p, 0, sizeof(p));
    const float* const* in = (const float* const*)d_in;
    p.x_prompt = in[0]; p.x_sample = in[1]; p.ck_a = in[2]; p.cv_a = in[3]; p.ck_w = in[4]; p.cv_w = in[5]; p.c = in[6]; p.c_ctx = in[7];
    p.w_mod = in[8]; p.b_mod = in[9]; p.g_mix = in[10]; p.g_ffn = in[11]; p.w_in = in[12]; p.gq_a = in[13]; p.gk_a = in[14]; p.gq_c = in[15]; p.gk_c = in[16];
    p.sink = in[17]; p.conv_w = in[18]; p.pool_w = in[19]; p.pool_scale = in[20]; p.w_br = in[21]; p.w_o = in[22]; p.w_gu = in[23]; p.w_down = in[24];
    p.out = (__attribute__((address_space(1))) float*)d_out;
    p.ws = (__attribute__((address_space(1))) unsigned char*)d_ws;
    if (WS_TOTAL > ws_size) { fprintf(stderr, "workspace too small: need %zu have %zu\n", (size_t)WS_TOTAL, ws_size); return; }
#if MK_MULTI
    for (int ph = 0; ph < NPHASE; ++ph) {
        p.phase_lo = ph; p.phase_hi = ph + 1;
        hipLaunchKernelGGL(fwd_megakernel, dim3(512), dim3(256), 0, stream, p);
    }
#else
    static int grid_blocks = 0;
    if (!grid_blocks) {
        int dev = 0, cus = 0, per_cu = 0;
        hipGetDevice(&dev);
        hipDeviceGetAttribute(&cus, hipDeviceAttributeMultiprocessorCount, dev);
        hipOccupancyMaxActiveBlocksPerMultiprocessor(&per_cu, fwd_megakernel, 256, 0);
        if (per_cu > 2) per_cu = 2;
        if (per_cu < 1) per_cu = 1;
        grid_blocks = cus * per_cu;
    }
    p.phase_lo = 0; p.phase_hi = NPHASE;
    (void)hipMemsetAsync((unsigned char*)d_ws + OFF_bar, 0, 16384, stream);
    void* args[] = {&p};
    hipError_t e = hipLaunchCooperativeKernel((void*)fwd_megakernel, dim3(grid_blocks), dim3(256), args, 0, stream);
    if (e != hipSuccess) fprintf(stderr, "cooperative launch failed: %s (grid %d)\n", hipGetErrorString(e), grid_blocks);
#endif
}
```

```cpp
#include <hip/hip_runtime.h>
#include <hip/hip_cooperative_groups.h>
#include <cstdio>
#include <cstdint>
#include <cstring>
namespace cg = cooperative_groups;

#ifndef PROBE2
#define PROBE2 0
#endif
#ifndef PROBE_REP
#define PROBE_REP 0
#endif
#ifndef PROBE_DRYBITS
#define PROBE_DRYBITS 8
#endif
#ifndef MK_MULTI
#define MK_MULTI 0
#endif

typedef unsigned short bf16_t;
typedef short bf16x8 __attribute__((ext_vector_type(8)));
typedef short s16x4 __attribute__((ext_vector_type(4)));
typedef float f32x16 __attribute__((ext_vector_type(16)));
typedef float f32x4 __attribute__((ext_vector_type(4)));
typedef unsigned u32x4 __attribute__((ext_vector_type(4)));
typedef unsigned u32x2 __attribute__((ext_vector_type(2)));
#define DI __device__ __forceinline__
#define LAS __attribute__((address_space(3)))

constexpr int NTOK = 6144, NCTX = 4096, DM = 1024, NIN = 7680, NPR = 3584, DFF = 2816, NL = 4;
constexpr float LOG2E = 1.4426950408889634f;
constexpr float QSCALE = 0.125f * LOG2E;
constexpr size_t OUT_KA = 6291456, OUT_VA = 8388608, OUT_KW = 10485760, OUT_VW = 12582912;
constexpr int NPHASE = 2 + 7 * NL;
constexpr float SSQ_SCALE = 256.f, SSQ_INV = 1.0f / 256.f, BIAS_SCALE = 16777216.f, BIAS_INV = 1.0f / 16777216.f;
constexpr int NBIAS = NIN + 2 * DFF;

constexpr size_t al256(size_t x) { return (x + 255) & ~(size_t)255; }
constexpr size_t OFF_bar = 0;
constexpr size_t OFF_mod = OFF_bar + al256(16384);
constexpr size_t OFF_rope = OFF_mod + al256((size_t)NL * 3 * 6144 * 4);
constexpr size_t OFF_WinT = OFF_rope + al256(2048 * 4);
constexpr size_t OFF_WbrT = OFF_WinT + al256((size_t)NL * NIN * DM * 2);
constexpr size_t OFF_WoT = OFF_WbrT + al256((size_t)NL * DM * 2048 * 2);
constexpr size_t OFF_WguT = OFF_WoT + al256((size_t)NL * DM * DM * 2);
constexpr size_t OFF_WdT = OFF_WguT + al256((size_t)NL * 2 * DFF * DM * 2);
constexpr size_t OFF_PoolT = OFF_WdT + al256((size_t)NL * DM * DFF * 2);
constexpr size_t OFF_h = OFF_PoolT + al256((size_t)NL * 4 * 128 * 128 * 2);
constexpr size_t OFF_P = OFF_h + al256((size_t)NTOK * DM * 2);
constexpr size_t OFF_gates = OFF_P + al256((size_t)NTOK * NPR * 4);
constexpr size_t OFF_qA = OFF_gates + al256((size_t)NTOK * 4096 * 2);
constexpr size_t OFF_qC = OFF_qA + al256((size_t)NTOK * 512 * 2);
constexpr size_t OFF_kAc = OFF_qC + al256((size_t)NTOK * 512 * 2);
constexpr size_t OFF_kCc = OFF_kAc + al256((size_t)NCTX * 128 * 2);
constexpr size_t OFF_kAl = OFF_kCc + al256((size_t)NCTX * 128 * 2);
constexpr size_t OFF_kCl = OFF_kAl + al256((size_t)NL * 2 * 1536 * 128 * 2);
constexpr size_t OFF_vAcT = OFF_kCl + al256((size_t)NL * 2 * 1536 * 128 * 2);
constexpr size_t OFF_vCcT = OFF_vAcT + al256((size_t)NCTX * 128 * 2);
constexpr size_t OFF_vAlT = OFF_vCcT + al256((size_t)NCTX * 128 * 2);
constexpr size_t OFF_vClT = OFF_vAlT + al256((size_t)NL * 2 * 1536 * 128 * 2);
constexpr size_t OFF_ypool = OFF_vClT + al256((size_t)NL * 2 * 1536 * 128 * 2);
constexpr size_t OFF_br = OFF_ypool + al256((size_t)NTOK * 512 * 2);
constexpr size_t OFF_merged = OFF_br + al256((size_t)NTOK * 2048 * 2);
constexpr size_t OFF_act = OFF_merged + al256((size_t)NTOK * DM * 2);
constexpr size_t OFF_ssq = OFF_act + al256((size_t)NTOK * DFF * 2);
constexpr size_t OFF_bias = OFF_ssq + al256((size_t)NL * 2 * NTOK * 4);
constexpr size_t WS_TOTAL = OFF_bias + al256((size_t)NL * 3 * NBIAS * 4);

struct Ctx { int tid, bid; };
struct Params {
    const float *x_prompt, *x_sample, *ck_a, *cv_a, *ck_w, *cv_w, *c, *c_ctx;
    const float *w_mod, *b_mod, *g_mix, *g_ffn, *w_in, *gq_a, *gk_a, *gq_c, *gk_c, *sink, *conv_w, *pool_w, *pool_scale, *w_br, *w_o, *w_gu, *w_down;
    __attribute__((address_space(1))) float* out;
    __attribute__((address_space(1))) unsigned char* ws;
    int phase_lo, phase_hi;
};

DI bf16_t f2bf(float x) { return __builtin_bit_cast(unsigned short, (__bf16)x); }
DI float bf2f(bf16_t v) { return __uint_as_float(((unsigned)v) << 16); }
DI unsigned pack2(float lo, float hi) {
    typedef __bf16 bf2 __attribute__((ext_vector_type(2)));
    typedef float f2 __attribute__((ext_vector_type(2)));
    f2 x = {lo, hi};
    return __builtin_bit_cast(unsigned, __builtin_convertvector(x, bf2));
}
DI size_t wtile_off(int n, int k, int K) { return ((size_t)(n >> 7) * (K >> 5) + (k >> 5)) * 4096 + (n & 127) * 32 + (k & 31); }
DI float wave_sum(float v) {
#pragma unroll
    for (int o = 32; o >= 1; o >>= 1) v += __shfl_xor(v, o);
    return v;
}
DI float fsigmoid(float x) { return __builtin_amdgcn_rcpf(1.f + __builtin_amdgcn_exp2f(-LOG2E * x)); }
DI void sigmoid16(const f32x16& x, float (&o)[16]) {
#pragma unroll
    for (int r = 0; r < 16; ++r) o[r] = x[r] * (-LOG2E);
    __builtin_amdgcn_sched_barrier(0);
#pragma unroll
    for (int r = 0; r < 16; ++r) o[r] = __builtin_amdgcn_exp2f(o[r]);
    __builtin_amdgcn_sched_barrier(0);
#pragma unroll
    for (int r = 0; r < 16; ++r) o[r] = 1.f + o[r];
#pragma unroll
    for (int r = 0; r < 16; ++r) o[r] = __builtin_amdgcn_rcpf(o[r]);
    __builtin_amdgcn_sched_barrier(0);
}
DI int condrow(int r) { return r < NCTX ? 0 : 1 + ((r - NCTX) >> 10); }

#define XB_TMO      128
#define XB_XCNT(j)  (256  + 64 * (j))
#define XB_XSUB(j)  (1280 + 64 * (j))
#define XB_XGEN(j)  (2304 + 64 * (j))
#define XB_TOP      3328
#define XB_TOPGEN   3392
#define XCD_BAR_WORDS 3456
#define XB_SPIN_CAP (1u << 22)
DI unsigned xb_ld(unsigned* p) { return __hip_atomic_load(p, __ATOMIC_RELAXED, __HIP_MEMORY_SCOPE_AGENT); }
DI unsigned xb_add(unsigned* p, unsigned v) { return __hip_atomic_fetch_add(p, v, __ATOMIC_RELAXED, __HIP_MEMORY_SCOPE_AGENT); }
DI unsigned xb_xcc_id() { return (unsigned)__builtin_amdgcn_s_getreg((3 << 11) | 20) & 0xFu; }
#define XB_SPIN(cond, bar) do { unsigned _sp = 0; while (cond) { __builtin_amdgcn_s_sleep(1); \
    if ((++_sp & 255u) == 0u) { if (xb_ld(&(bar)[XB_TMO])) break; if (_sp > XB_SPIN_CAP) { atomicAdd(&(bar)[XB_TMO], 1u); break; } } } } while (0)
struct XcdBarrier { unsigned* bar; unsigned x; volatile LAS unsigned* st; };
DI XcdBarrier xcd_barrier_post(unsigned* bar, volatile LAS unsigned* st) {
    XcdBarrier b; b.bar = bar; b.x = xb_xcc_id(); b.st = st;
    if (threadIdx.x == 0) (void)xb_add(&bar[XB_XCNT(b.x)], 1u);
    return b;
}
DI void xcd_barrier_complete(unsigned* bar, unsigned x, unsigned& nloc, unsigned& nx) {
    const unsigned G = gridDim.x * gridDim.y * gridDim.z;
    unsigned sum, cnt, mine, sp = 0u;
    for (;;) {
        sum = 0u; cnt = 0u; mine = 0u;
#pragma unroll
        for (unsigned j = 0; j < 16; ++j) { const unsigned c = xb_ld(&bar[XB_XCNT(j)]); sum += c; cnt += (c > 0u) ? 1u : 0u; mine = (j == x) ? c : mine; }
        if (sum == G) break;
        __builtin_amdgcn_s_sleep(1);
        if ((++sp & 255u) == 0u) { if (xb_ld(&bar[XB_TMO])) break; if (sp > XB_SPIN_CAP) { atomicAdd(&bar[XB_TMO], 1u); break; } }
    }
    nloc = mine > 0u ? mine : 1u; nx = cnt > 0u ? cnt : 1u;
}
DI void xcd_barrier(const XcdBarrier& b) {
    asm volatile("s_waitcnt vmcnt(0)" ::: "memory");
    __syncthreads();
    if (threadIdx.x == 0) {
        unsigned* bar = b.bar;
        __builtin_amdgcn_s_waitcnt(0);
        unsigned nloc = b.st[0], nx = b.st[1];
        if (nloc == 0u) { xcd_barrier_complete(bar, b.x, nloc, nx); b.st[0] = nloc; b.st[1] = nx; }
        const unsigned old = xb_add(&bar[XB_XSUB(b.x)], 1u);
        const unsigned gen = old / nloc;
        if (old + 1u == (gen + 1u) * nloc) {
            __builtin_amdgcn_fence(__ATOMIC_RELEASE, "agent");
            asm volatile("s_waitcnt vmcnt(0)" ::: "memory");
            const unsigned og = xb_add(&bar[XB_TOP], 1u);
            const unsigned tg = og / nx;
            if (og + 1u == (tg + 1u) * nx) xb_add(&bar[XB_TOPGEN], 1u);
            else XB_SPIN(xb_ld(&bar[XB_TOPGEN]) == tg, bar);
            __builtin_amdgcn_fence(__ATOMIC_ACQUIRE, "agent");
            xb_add(&bar[XB_XGEN(b.x)], 1u);
            asm volatile("s_waitcnt vmcnt(0)" ::: "memory");
        } else {
            XB_SPIN(xb_ld(&bar[XB_XGEN(b.x)]) == gen, bar);
            __builtin_amdgcn_fence(__ATOMIC_ACQUIRE, "agent");
            asm volatile("s_waitcnt vmcnt(0)" ::: "memory");
        }
    }
    __syncthreads();
}

DI void transpose_tile(const Ctx& cx, const float* __restrict__ src, int ldsrc, int k0, int n0, bf16_t* __restrict__ dst, int ldd, int dcol0, int drow0, unsigned char* smem,
                       const float* shp = nullptr, float* biasp = nullptr) {
    float* T = (float*)smem;
    const int tid = cx.tid;
    const int kk = tid >> 4, c4 = (tid & 15) * 4;
    f32x4 v[4];
#pragma unroll
    for (int i = 0; i < 4; ++i) v[i] = __builtin_nontemporal_load((const f32x4*)(src + (size_t)(k0 + kk + 16 * i) * ldsrc + n0 + c4));
    __builtin_amdgcn_sched_barrier(0);
#pragma unroll
    for (int i = 0; i < 4; ++i) {
        float* t = T + (kk + 16 * i) * 65 + c4;
        t[0] = v[i][0]; t[1] = v[i][1]; t[2] = v[i][2]; t[3] = v[i][3];
    }
    float* SH = T + 64 * 65;
    if (shp && tid < 192) SH[tid] = shp[(tid >> 6) * 6144 + k0 + (tid & 63)];
    __syncthreads();
    const int nl = tid >> 2, kq = tid & 3;
    float tv[16];
#pragma unroll
    for (int j = 0; j < 16; ++j) tv[j] = T[(kq * 16 + j) * 65 + nl];
    unsigned w[8];
#pragma unroll
    for (int j = 0; j < 8; ++j) w[j] = pack2(tv[2 * j], tv[2 * j + 1]);
    bf16_t* d = dst + wtile_off(drow0 + nl, dcol0 + k0 + kq * 16, ldd);
    *(u32x4*)d = (u32x4){w[0], w[1], w[2], w[3]};
    *(u32x4*)(d + 8) = (u32x4){w[4], w[5], w[6], w[7]};
    if (shp) {
#pragma unroll
        for (int cr = 0; cr < 3; ++cr) {
            float a = 0.f;
#pragma unroll
            for (int q4 = 0; q4 < 4; ++q4) {
                const f32x4 s4 = *(const f32x4*)(SH + cr * 64 + kq * 16 + q4 * 4);
                a += s4[0] * tv[q4 * 4] + s4[1] * tv[q4 * 4 + 1] + s4[2] * tv[q4 * 4 + 2] + s4[3] * tv[q4 * 4 + 3];
            }
            a += __shfl_xor(a, 1); a += __shfl_xor(a, 2);
            if (kq == 0) atomicAdd((int*)biasp + cr * NBIAS + drow0 + nl, (int)lrintf(a * BIAS_SCALE));
        }
    }
    __syncthreads();
}

DI void prologue_transpose(const Ctx& cx, const Params& p, int u, unsigned char* smem) {
    const int l = u / 4816; int i = u % 4816;
    if (i < 1920) { const int kt = i & 15, nt = i >> 4;
        transpose_tile(cx, p.w_in + (size_t)l * DM * NIN, NIN, kt * 64, nt * 64, ((bf16_t*)(p.ws + OFF_WinT)) + (size_t)l * NIN * DM, DM, 0, nt * 64, smem,
                       ((float*)(p.ws + OFF_mod)) + (size_t)l * 3 * 6144, ((float*)(p.ws + OFF_bias)) + (size_t)l * 3 * NBIAS); return; }
    i -= 1920;
    if (i < 512) { const int brn = i >> 7; const int j = i & 127; const int kt = j & 7, nt = j >> 3;
        transpose_tile(cx, p.w_br + ((size_t)l * 4 + brn) * 512 * DM, DM, kt * 64, nt * 64, ((bf16_t*)(p.ws + OFF_WbrT)) + (size_t)l * DM * 2048, 2048, brn * 512, nt * 64, smem); return; }
    i -= 512;
    if (i < 256) { const int kt = i & 15, nt = i >> 4;
        transpose_tile(cx, p.w_o + (size_t)l * DM * DM, DM, kt * 64, nt * 64, ((bf16_t*)(p.ws + OFF_WoT)) + (size_t)l * DM * DM, DM, 0, nt * 64, smem); return; }
    i -= 256;
    if (i < 1408) { const int kt = i & 15, nt = i >> 4;
        const int isb = nt >= 44; const int j0 = (nt - (isb ? 44 : 0)) * 64;
        float* T = (float*)smem;
        const int tid = cx.tid; const int kk = tid >> 4, c4 = (tid & 15) * 4;
        const float* src = p.w_gu + (size_t)l * DM * 2 * DFF;
        f32x4 v[4];
#pragma unroll
        for (int q = 0; q < 4; ++q) v[q] = __builtin_nontemporal_load((const f32x4*)(src + (size_t)(kt * 64 + kk + 16 * q) * (2 * DFF) + nt * 64 + c4));
        __builtin_amdgcn_sched_barrier(0);
#pragma unroll
        for (int q = 0; q < 4; ++q) {
            float* t = T + (kk + 16 * q) * 65 + c4;
            t[0] = v[q][0]; t[1] = v[q][1]; t[2] = v[q][2]; t[3] = v[q][3];
        }
        float* SH = T + 64 * 65;
        if (tid < 192) SH[tid] = ((float*)(p.ws + OFF_mod))[(size_t)(l * 3 + (tid >> 6)) * 6144 + 3072 + kt * 64 + (tid & 63)];
        __syncthreads();
        const int nl = tid >> 2, kq = tid & 3;
        float tv[16];
#pragma unroll
        for (int j = 0; j < 16; ++j) tv[j] = T[(kq * 16 + j) * 65 + nl];
        unsigned w[8];
#pragma unroll
        for (int j = 0; j < 8; ++j) w[j] = pack2(tv[2 * j], tv[2 * j + 1]);
        const int drow = (j0 >> 5) * 64 + isb * 32 + nl + (nl >= 32 ? 32 : 0);
        bf16_t* d = ((bf16_t*)(p.ws + OFF_WguT)) + (size_t)l * 2 * DFF * DM + wtile_off(drow, kt * 64 + kq * 16, DM);
        *(u32x4*)d = (u32x4){w[0], w[1], w[2], w[3]};
        *(u32x4*)(d + 8) = (u32x4){w[4], w[5], w[6], w[7]};
        {
            const int drn = (j0 >> 5) * 64 + isb * 32 + nl + (nl >= 32 ? 32 : 0);
#pragma unroll
            for (int cr = 0; cr < 3; ++cr) {
                float a = 0.f;
#pragma unroll
                for (int q4 = 0; q4 < 4; ++q4) {
                    const f32x4 s4 = *(const f32x4*)(SH + cr * 64 + kq * 16 + q4 * 4);
                    a += s4[0] * tv[q4 * 4] + s4[1] * tv[q4 * 4 + 1] + s4[2] * tv[q4 * 4 + 2] + s4[3] * tv[q4 * 4 + 3];
                }
                a += __shfl_xor(a, 1); a += __shfl_xor(a, 2);
                if (kq == 0) atomicAdd(((int*)(p.ws + OFF_bias)) + (size_t)(l * 3 + cr) * NBIAS + NIN + drn, (int)lrintf(a * BIAS_SCALE));
            }
        }
        __syncthreads();
        return; }
    i -= 1408;
    if (i < 704) { const int kt = i % 44, nt = i / 44;
        transpose_tile(cx, p.w_down + (size_t)l * DFF * DM, DM, kt * 64, nt * 64, ((bf16_t*)(p.ws + OFF_WdT)) + (size_t)l * DM * DFF, DFF, 0, nt * 64, smem); return; }
    i -= 704;
    { const int g = i >> 2; const int kt = i & 1, nt = (i >> 1) & 1;
        transpose_tile(cx, p.pool_w + ((size_t)l * 4 + g) * 128 * 128, 128, kt * 64, nt * 64, ((bf16_t*)(p.ws + OFF_PoolT)) + ((size_t)l * 4 + g) * 128 * 128, 128, 0, nt * 64, smem); }
}

DI void prologue_mod(const Ctx& cx, const Params& p, int u, unsigned char* smem) {
    const int l = u / 96, chunk = u % 96;
    const int tid = cx.tid, cgp = tid & 15, ks = tid >> 4;
    float* S = (float*)smem;
    float* red = S + 3 * 1024;
#pragma unroll
    for (int j = 0; j < 4; ++j) {
        const int k = tid + 256 * j;
        const float c0 = p.c_ctx[k], c1 = p.c[k], c2 = p.c[DM + k];
        S[k] = c0 / (1.f + __expf(-c0)); S[1024 + k] = c1 / (1.f + __expf(-c1)); S[2048 + k] = c2 / (1.f + __expf(-c2));
    }
    __syncthreads();
    const float* w = p.w_mod + (size_t)l * DM * 6144 + chunk * 64 + cgp * 4;
    float a[3][4];
#pragma unroll
    for (int r = 0; r < 3; ++r)
#pragma unroll
        for (int j = 0; j < 4; ++j) a[r][j] = 0.f;
#pragma unroll 1
    for (int kb = 0; kb < 64; kb += 16) {
        f32x4 wv[16];
#pragma unroll
        for (int q = 0; q < 16; ++q) wv[q] = __builtin_nontemporal_load((const f32x4*)(w + (size_t)(ks * 64 + kb + q) * 6144));
        __builtin_amdgcn_sched_barrier(0);
#pragma unroll
        for (int q = 0; q < 16; ++q) {
            const int k = ks * 64 + kb + q;
            const float s0 = S[k], s1 = S[1024 + k], s2 = S[2048 + k];
#pragma unroll
            for (int j = 0; j < 4; ++j) { a[0][j] += s0 * wv[q][j]; a[1][j] += s1 * wv[q][j]; a[2][j] += s2 * wv[q][j]; }
        }
    }
#pragma unroll
    for (int r = 0; r < 3; ++r)
#pragma unroll
        for (int j = 0; j < 4; ++j) red[(ks * 3 + r) * 64 + cgp * 4 + j] = a[r][j];
    __syncthreads();
    if (tid < 192) {
        const int r = tid >> 6, nn = tid & 63;
        float v = p.b_mod[l * 6144 + chunk * 64 + nn];
#pragma unroll
        for (int q = 0; q < 16; ++q) v += red[(q * 3 + r) * 64 + nn];
        ((float*)(p.ws + OFF_mod))[(size_t)(l * 3 + r) * 6144 + chunk * 64 + nn] = v;
    }
    __syncthreads();
}

DI void prologue_misc(const Ctx& cx, const Params& p, int u) {
    const int tid = cx.tid;
    if (u < 768) {
        const f32x4* a = (const f32x4*)p.x_prompt; const f32x4* b = (const f32x4*)p.x_sample; f32x4* o = (f32x4*)p.out;
#pragma unroll
        for (int j = 0; j < 8; ++j) { const int idx = u * 2048 + tid + 256 * j; o[idx] = __builtin_nontemporal_load(idx < 1048576 ? a + idx : b + (idx - 1048576)); }
        return;
    }
    u -= 768;
    if (u < 512) {
        const int e = (u * 256 + tid) * 8;
        const int which = e >> 19, rem = e & ((1 << 19) - 1);
        const int b = rem >> 18, l = (rem >> 16) & 3, s = (rem >> 7) & 511, c = rem & 127;
        const float* src = (which ? p.ck_w : p.ck_a) + rem;
        const f32x4 v0 = __builtin_nontemporal_load((const f32x4*)src), v1 = __builtin_nontemporal_load((const f32x4*)(src + 4));
        bf16_t* dst = (which ? ((bf16_t*)(p.ws + OFF_kCl)) : ((bf16_t*)(p.ws + OFF_kAl))) + ((size_t)((l * 2 + b) * 1536 + s)) * 128 + c;
        *(u32x4*)dst = (u32x4){pack2(v0[0], v0[1]), pack2(v0[2], v0[3]), pack2(v1[0], v1[1]), pack2(v1[2], v1[3])};
        return;
    }
    u -= 512;
    if (u < 64) {
        const int which = u >> 5, l = (u >> 3) & 3, b = (u >> 2) & 1, sp = u & 3;
        const int col = tid & 127, s0 = (sp * 2 + (tid >> 7)) * 64;
        const float* src = (which ? p.cv_w : p.cv_a) + ((size_t)((b * 4 + l) * 512 + s0)) * 128 + col;
        bf16_t* dst = (which ? ((bf16_t*)(p.ws + OFF_vClT)) : ((bf16_t*)(p.ws + OFF_vAlT))) + ((size_t)((l * 2 + b) * 128 + col)) * 1536 + s0;
        float v[64];
#pragma unroll
        for (int j = 0; j < 64; ++j) v[j] = __builtin_nontemporal_load(src + (size_t)j * 128);
        __builtin_amdgcn_sched_barrier(0);
#pragma unroll
        for (int jc = 0; jc < 8; ++jc)
            *(u32x4*)(dst + jc * 8) = (u32x4){pack2(v[jc * 8 + 0], v[jc * 8 + 1]), pack2(v[jc * 8 + 2], v[jc * 8 + 3]), pack2(v[jc * 8 + 4], v[jc * 8 + 5]), pack2(v[jc * 8 + 6], v[jc * 8 + 7])};
        return;
    }
    u -= 64;
    if (u < 51) {
        f32x4* z = (f32x4*)(p.ws + OFF_ssq);
        const int n4 = (int)((WS_TOTAL - OFF_ssq) / 16);
        const float zf = __int_as_float(tid >> 20);
#pragma unroll
        for (int j = 0; j < 4; ++j) { const int idx = u * 1024 + tid + 256 * j; if (idx < n4) z[idx] = (f32x4){zf, zf, zf, zf}; }
        return;
    }
    u -= 51;
    {
#pragma unroll
        for (int j = 0; j < 4; ++j) {
            const int idx = tid + 256 * j; const int pos = idx >> 4, i = idx & 15;
            const float inv = 1.0f / powf(10000.0f, (float)i / 16.0f);
            const float ang = (float)pos * inv;
            ((float*)(p.ws + OFF_rope))[idx] = cosf(ang); ((float*)(p.ws + OFF_rope))[1024 + idx] = sinf(ang);
        }
    }
}
constexpr int PRO_T = 4816, PRO_MOD = 96 * NL, PRO_MISC = 768 + 512 + 64 + 51 + 1;

DI void x0_rows(const Ctx& cx, const Params& p, int r0, int rstride) {
    const int lane = cx.tid & 63;
    f32x4 v[3][4];
#pragma unroll
    for (int q = 0; q < 3; ++q) {
        const f32x4* x = (const f32x4*)(p.out + (size_t)(r0 + q * rstride) * DM);
#pragma unroll
        for (int i = 0; i < 4; ++i) v[q][i] = x[lane + 64 * i];
    }
    f32x4 gv[4];
#pragma unroll
    for (int i = 0; i < 4; ++i) gv[i] = *(const f32x4*)(p.g_mix + (lane + 64 * i) * 4);
    f32x4 scv[3][4];
#pragma unroll
    for (int q = 0; q < 3; ++q)
#pragma unroll
        for (int i = 0; i < 4; ++i) scv[q][i] = *(const f32x4*)(((float*)(p.ws + OFF_mod)) + (size_t)condrow(r0 + q * rstride) * 6144 + DM + (lane + 64 * i) * 4);
    __builtin_amdgcn_sched_barrier(0);
#pragma unroll
    for (int q = 0; q < 3; ++q) {
        const int r = r0 + q * rstride;
        float a = 0.f;
#pragma unroll
        for (int i = 0; i < 4; ++i) a += v[q][i][0] * v[q][i][0] + v[q][i][1] * v[q][i][1] + v[q][i][2] * v[q][i][2] + v[q][i][3] * v[q][i][3];
        a = wave_sum(a);
        if (lane == 0) ((unsigned*)(p.ws + OFF_ssq))[r] = (unsigned)(a * SSQ_SCALE + 0.5f);
#pragma unroll
        for (int i = 0; i < 4; ++i) {
            const int c = (lane + 64 * i) * 4;
            const f32x4 sc = scv[q][i];
            float o[4];
#pragma unroll
            for (int j = 0; j < 4; ++j) o[j] = v[q][i][j] * gv[i][j] * (1.f + sc[j]);
            *(u32x2*)(((bf16_t*)(p.ws + OFF_h)) + wtile_off(r, c, DM)) = (u32x2){pack2(o[0], o[1]), pack2(o[2], o[3])};
        }
    }
}

enum { E_IN = 0, E_BR = 1, E_RES = 2, E_GU = 3, E_POOL = 4 };
struct GemmArgs { const bf16_t* A; int lda; const bf16_t* Bt; int ldb; int K; int row0, col0; int layer; int aux; int atk; };
constexpr int STG_B = 16384;
#define GL_WAIT(n) asm volatile("s_waitcnt vmcnt(" #n ")" ::: "memory")
#define GL_BAR() do { asm volatile("s_waitcnt lgkmcnt(0)" ::: "memory"); __builtin_amdgcn_s_barrier(); } while (0)

template <int EPI> DI void gemm_tile(const Ctx& cx, const Params& p, const GemmArgs& g, unsigned char* smem, bool pre, bool hn, const GemmArgs& gn) {
    const int tid = cx.tid, wid = tid >> 6, lane = tid & 63, l31 = lane & 31, hh = lane >> 5, wm = wid >> 1, wn = wid & 1;
    f32x16 acc[2][2], tot[2][2];
#pragma unroll
    for (int a = 0; a < 2; ++a)
#pragma unroll
        for (int b = 0; b < 2; ++b)
#pragma unroll
            for (int r = 0; r < 16; ++r) { acc[a][b][r] = 0.f; tot[a][b][r] = 0.f; }
    float rs[2][16]; float bcol[2]; float sraw = 0.f;
    if (EPI == E_IN || EPI == E_GU) {
        if (tid < 128) sraw = ((const float*)(p.ws + OFF_ssq))[(size_t)(g.layer * 2 + (EPI == E_GU ? 1 : 0)) * NTOK + g.row0 + tid];
        const float* bp = ((float*)(p.ws + OFF_bias)) + (size_t)(g.layer * 3 + condrow(g.row0)) * NBIAS + (EPI == E_GU ? NIN : 0) + g.col0 + wn * 64 + l31;
        bcol[0] = bp[0]; bcol[1] = bp[32];
    }
    const int nk = g.K >> 5;
    const int lrow = wid * 32 + (lane >> 2);
    const int lsw = (lane & 3) ^ ((lane >> 4) & 3);
    const int lr0 = (g.aux & 16) ? 0 : g.row0, lc0 = (g.aux & 16) ? 0 : g.col0;
    const int ars = g.atk ? 32 : g.lda;
    const size_t aks = g.atk ? 4096 : 32;
    const bf16_t* Ag = g.A + (g.atk ? ((size_t)(lr0 >> 7) * g.atk) * 4096 : (size_t)lr0 * g.lda) + (size_t)lrow * ars + lsw * 8;
    const bf16_t* Bg = g.Bt + ((size_t)(g.col0 >> 7) * (g.K >> 5)) * 4096 + lrow * 32 + lsw * 8;
    const size_t a16 = (size_t)16 * g.lda, b16 = (size_t)16 * g.ldb;
    unsigned char* lbase = smem + wid * 2048;
    auto issue = [&](int kt, int buf) {
        unsigned char* d = lbase + buf * STG_B;
        __builtin_amdgcn_global_load_lds((const unsigned*)(Ag + kt * aks), (unsigned*)d, 16, 0, 0);
        __builtin_amdgcn_global_load_lds((const unsigned*)(Ag + 16 * ars + kt * aks), (unsigned*)(d + 1024), 16, 0, 0);
        __builtin_amdgcn_global_load_lds((const unsigned*)(Bg + (size_t)kt * 4096), (unsigned*)(d + 8192), 16, 0, 0);
        __builtin_amdgcn_global_load_lds((const unsigned*)(Bg + (size_t)kt * 4096 + 512), (unsigned*)(d + 8192 + 1024), 16, 0, 0);
    };
    const int sw = (l31 >> 2) & 3;
    const int offA = (wm * 64 + l31) * 64, offB = 8192 + (wn * 64 + l31) * 64;
    const int c0 = ((0 + hh) ^ sw) * 16, c1 = ((2 + hh) ^ sw) * 16;
    if (!pre) { issue(0, 0); issue(1, 1); issue(2, 2); }
    for (int kt0 = 0; kt0 < nk; kt0 += 4) {
#pragma unroll
        for (int u = 0; u < 4; ++u) {
            const int kt = kt0 + u;
            if (pre && kt == 0) GL_WAIT(0);
            else if (kt + 2 < nk) GL_WAIT(8); else if (kt + 1 < nk) GL_WAIT(4); else GL_WAIT(0);
            GL_BAR();
            const unsigned char* sb = smem + u * STG_B;
            const bf16x8 a00 = *(const bf16x8*)(sb + offA + c0), a10 = *(const bf16x8*)(sb + offA + 2048 + c0);
            const bf16x8 b00 = *(const bf16x8*)(sb + offB + c0), b10 = *(const bf16x8*)(sb + offB + 2048 + c0);
            const bf16x8 a01 = *(const bf16x8*)(sb + offA + c1), a11 = *(const bf16x8*)(sb + offA + 2048 + c1);
            const bf16x8 b01 = *(const bf16x8*)(sb + offB + c1), b11 = *(const bf16x8*)(sb + offB + 2048 + c1);
            __builtin_amdgcn_sched_barrier(0);
            if (kt + 3 < nk) issue(kt + 3, (u + 3) & 3);
            __builtin_amdgcn_sched_barrier(0);
            acc[0][0] = __builtin_amdgcn_mfma_f32_32x32x16_bf16(a00, b00, acc[0][0], 0, 0, 0);
            acc[0][1] = __builtin_amdgcn_mfma_f32_32x32x16_bf16(a00, b10, acc[0][1], 0, 0, 0);
            acc[1][0] = __builtin_amdgcn_mfma_f32_32x32x16_bf16(a10, b00, acc[1][0], 0, 0, 0);
            acc[1][1] = __builtin_amdgcn_mfma_f32_32x32x16_bf16(a10, b10, acc[1][1], 0, 0, 0);
            acc[0][0] = __builtin_amdgcn_mfma_f32_32x32x16_bf16(a01, b01, acc[0][0], 0, 0, 0);
            acc[0][1] = __builtin_amdgcn_mfma_f32_32x32x16_bf16(a01, b11, acc[0][1], 0, 0, 0);
            acc[1][0] = __builtin_amdgcn_mfma_f32_32x32x16_bf16(a11, b01, acc[1][0], 0, 0, 0);
            acc[1][1] = __builtin_amdgcn_mfma_f32_32x32x16_bf16(a11, b11, acc[1][1], 0, 0, 0);
        }
        if (EPI == E_BR && (kt0 & 15) == 12) {
            const int kbr = kt0 >> 4;
            const bf16_t* gp = ((bf16_t*)(p.ws + OFF_gates)) + (size_t)(((g.row0 >> 7) * 4 + kbr) * 8 + (g.col0 >> 7)) * 16384 + tid * 8;
#pragma unroll
            for (int mi = 0; mi < 2; ++mi) {
                u32x4 gw[4];
#pragma unroll
                for (int q = 0; q < 4; ++q) gw[q] = __builtin_nontemporal_load((const u32x4*)(gp + (mi * 4 + q) * 2048));
#pragma unroll
                for (int ni = 0; ni < 2; ++ni)
#pragma unroll
                    for (int r = 0; r < 16; ++r) {
                        const unsigned w = gw[ni * 2 + (r >> 3)][(r & 7) >> 1];
                        const float gv = (r & 1) ? __uint_as_float(w & 0xffff0000u) : __uint_as_float(w << 16);
                        tot[mi][ni][r] += gv * acc[mi][ni][r]; acc[mi][ni][r] = 0.f;
                    }
            }
        }
    }
    if ((EPI == E_IN || EPI == E_GU) && tid < 128)
        ((float*)(smem + 69632))[tid] = rsqrtf((float)__float_as_uint(sraw) * (SSQ_INV / DM) + 1e-6f);
    GL_BAR();
    if (hn) {
        const bf16_t* An = gn.A + (gn.atk ? ((size_t)(gn.row0 >> 7) * gn.atk) * 4096 : (size_t)gn.row0 * gn.lda) + (size_t)lrow * ars + lsw * 8;
        const bf16_t* Bn = gn.Bt + ((size_t)(gn.col0 >> 7) * (gn.K >> 5)) * 4096 + lrow * 32 + lsw * 8;
#pragma unroll
        for (int st = 0; st < 3; ++st) {
            unsigned char* d = lbase + st * STG_B;
            __builtin_amdgcn_global_load_lds((const unsigned*)(An + st * aks), (unsigned*)d, 16, 0, 0);
            __builtin_amdgcn_global_load_lds((const unsigned*)(An + 16 * ars + st * aks), (unsigned*)(d + 1024), 16, 0, 0);
            __builtin_amdgcn_global_load_lds((const unsigned*)(Bn + (size_t)st * 4096), (unsigned*)(d + 8192), 16, 0, 0);
            __builtin_amdgcn_global_load_lds((const unsigned*)(Bn + (size_t)st * 4096 + 512), (unsigned*)(d + 8192 + 1024), 16, 0, 0);
        }
    }
    if (EPI == E_IN || EPI == E_GU) {
#pragma unroll
        for (int mi = 0; mi < 2; ++mi)
#pragma unroll
            for (int r4 = 0; r4 < 4; ++r4) {
                const f32x4 q4 = *(const f32x4*)((const float*)(smem + 69632) + wm * 64 + mi * 32 + 8 * r4 + 4 * hh);
                rs[mi][4 * r4 + 0] = q4[0]; rs[mi][4 * r4 + 1] = q4[1]; rs[mi][4 * r4 + 2] = q4[2]; rs[mi][4 * r4 + 3] = q4[3];
            }
        bcol[0] = (float)__float_as_int(bcol[0]) * BIAS_INV; bcol[1] = (float)__float_as_int(bcol[1]) * BIAS_INV;
    }
    if (EPI == E_IN && g.col0 >= NPR) {
        const int gc = g.col0 - NPR;
        bf16_t* gp = ((bf16_t*)(p.ws + OFF_gates)) + (size_t)(((g.row0 >> 7) * 4 + (gc >> 10)) * 8 + ((gc & 1023) >> 7)) * 16384 + tid * 8;
#pragma unroll
        for (int mi = 0; mi < 2; ++mi)
#pragma unroll
            for (int ni = 0; ni < 2; ++ni) {
                float sg[16]; f32x16 xv;
#pragma unroll
                for (int r = 0; r < 16; ++r) xv[r] = acc[mi][ni][r] * rs[mi][r] + bcol[ni];
                sigmoid16(xv, sg);
                *(u32x4*)(gp + ((mi * 2 + ni) * 2) * 2048) = (u32x4){pack2(sg[0], sg[1]), pack2(sg[2], sg[3]), pack2(sg[4], sg[5]), pack2(sg[6], sg[7])};
                *(u32x4*)(gp + ((mi * 2 + ni) * 2 + 1) * 2048) = (u32x4){pack2(sg[8], sg[9]), pack2(sg[10], sg[11]), pack2(sg[12], sg[13]), pack2(sg[14], sg[15])};
            }
        return;
    }
    if (EPI == E_IN || EPI == E_GU || EPI == E_BR) {
        constexpr int OW = (EPI == E_GU) ? 64 : 128;
        constexpr int OS = OW + 8;
        constexpr int NH = (EPI == E_GU) ? 1 : 2;
        constexpr int RH = 128 / NH;
        constexpr int CPR = OW / 8;
        constexpr int OLD = (EPI == E_GU) ? DFF : (EPI == E_BR) ? DM : NPR;
        bf16_t* T = (bf16_t*)(smem + 3 * STG_B);
        bf16_t* O = (EPI == E_GU) ? ((bf16_t*)(p.ws + OFF_act)) + (size_t)g.row0 * DFF + (g.col0 >> 1)
                  : (EPI == E_BR) ? ((bf16_t*)(p.ws + OFF_merged)) + (size_t)g.row0 * DM + g.col0
                                  : ((bf16_t*)(p.ws + OFF_P)) + (size_t)g.row0 * NPR + g.col0;
#pragma unroll
        for (int hf = 0; hf < NH; ++hf) {
            if (NH == 1 || wm == hf) {
#pragma unroll
                for (int mi = 0; mi < 2; ++mi) {
                    float sg[16];
                    if (EPI == E_GU) {
                        f32x16 av;
#pragma unroll
                        for (int r = 0; r < 16; ++r) av[r] = acc[mi][0][r] * rs[mi][r] + bcol[0];
                        sigmoid16(av, sg);
#pragma unroll
                        for (int r = 0; r < 16; ++r) sg[r] = av[r] * sg[r] * (acc[mi][1][r] * rs[mi][r] + bcol[1]);
                    }
#pragma unroll
                    for (int r = 0; r < 16; ++r) {
                        const int rl = (NH == 1 ? wm * 64 : 0) + mi * 32 + (r & 3) + 8 * (r >> 2) + 4 * hh;
                        if (EPI == E_GU) {
                            T[rl * OS + wn * 32 + l31] = f2bf(sg[r]);
                        } else if (EPI == E_BR) {
                            T[rl * OS + wn * 64 + l31] = f2bf(tot[mi][0][r]);
                            T[rl * OS + wn * 64 + 32 + l31] = f2bf(tot[mi][1][r]);
                        } else {
                            T[rl * OS + wn * 64 + l31] = f2bf(acc[mi][0][r] * rs[mi][r] + bcol[0]);
                            T[rl * OS + wn * 64 + 32 + l31] = f2bf(acc[mi][1][r] * rs[mi][r] + bcol[1]);
                        }
                    }
                }
            }
            GL_BAR();
#pragma unroll
            for (int i = 0; i < (RH * CPR) / 256; ++i) {
                const int ch = tid + 256 * i; const int rr = ch / CPR, cc = ch % CPR;
                bf16_t* od;
                if (EPI == E_GU) od = ((bf16_t*)(p.ws + OFF_act)) + wtile_off(g.row0 + hf * RH + rr, (g.col0 >> 1) + cc * 8, DFF);
                else if (EPI == E_BR) od = ((bf16_t*)(p.ws + OFF_merged)) + wtile_off(g.row0 + hf * RH + rr, g.col0 + cc * 8, DM);
                else od = O + (size_t)(hf * RH + rr) * OLD + cc * 8;
                *(u32x4*)od = *(const u32x4*)(T + rr * OS + cc * 8);
            }
            GL_BAR();
        }
        return;
    }
    if (EPI == E_RES) {
        const int cr = condrow(g.row0), which = g.aux & 7;
        const bool mk = (which == 2) || (g.layer + 1 < NL);
        const int nl = which == 2 ? g.layer : g.layer + 1;
        const float* modc = ((float*)(p.ws + OFF_mod)) + (size_t)(g.layer * 3 + cr) * 6144 + which * DM;
        float gm[2];
        gm[0] = modc[g.col0 + wn * 64 + l31]; gm[1] = modc[g.col0 + wn * 64 + 32 + l31];
        const int cq = tid & 31;
        f32x4 gn4 = (f32x4){0.f, 0.f, 0.f, 0.f};
        if (mk) {
            const f32x4 gg = *(const f32x4*)((which == 2 ? p.g_ffn : p.g_mix) + nl * DM + g.col0 + cq * 4);
            const f32x4 sc = *(const f32x4*)(((float*)(p.ws + OFF_mod)) + (size_t)(nl * 3 + cr) * 6144 + (which == 2 ? 4 : 1) * DM + g.col0 + cq * 4);
            gn4 = gg * (1.f + sc);
        }
        unsigned* ssq = ((unsigned*)(p.ws + OFF_ssq)) + (size_t)(nl * 2 + (which == 2 ? 1 : 0)) * NTOK;
        float* Dl = (float*)smem;
#pragma unroll
        for (int mi = 0; mi < 2; ++mi) {
            f32x4 xo[8];
#pragma unroll
            for (int i = 0; i < 8; ++i) {
                const int rr = (tid >> 5) + 8 * i;
                xo[i] = *(const f32x4*)((const float*)(p.out) + (size_t)(g.row0 + (rr >> 5) * 64 + mi * 32 + (rr & 31)) * DM + g.col0 + cq * 4);
            }
#pragma unroll
            for (int r = 0; r < 16; ++r) {
                const int rl = wm * 32 + (r & 3) + 8 * (r >> 2) + 4 * hh;
                Dl[rl * 132 + wn * 64 + l31] = gm[0] * acc[mi][0][r];
                Dl[rl * 132 + wn * 64 + 32 + l31] = gm[1] * acc[mi][1][r];
            }
            GL_BAR();
#pragma unroll
            for (int i = 0; i < 8; ++i) {
                const int rr = (tid >> 5) + 8 * i;
                const int row = g.row0 + (rr >> 5) * 64 + mi * 32 + (rr & 31);
                const f32x4 xn = xo[i] + *(const f32x4*)(Dl + rr * 132 + cq * 4);
                *(f32x4*)((float*)(p.out) + (size_t)row * DM + g.col0 + cq * 4) = xn;
                if (mk) {
                    const f32x4 hv = xn * gn4;
                    *(u32x2*)(((bf16_t*)(p.ws + OFF_h)) + wtile_off(row, g.col0 + cq * 4, DM)) = (u32x2){pack2(hv[0], hv[1]), pack2(hv[2], hv[3])};
                    float sq = xn[0] * xn[0] + xn[1] * xn[1] + xn[2] * xn[2] + xn[3] * xn[3];
#pragma unroll
                    for (int o2 = 16; o2 >= 1; o2 >>= 1) sq += __shfl_xor(sq, o2);
                    if (cq == 0) atomicAdd(ssq + row, (unsigned)(sq * SSQ_SCALE + 0.5f));
                }
            }
            GL_BAR();
        }
        return;
    }
#pragma unroll
    for (int mi = 0; mi < 2; ++mi)
#pragma unroll
        for (int r = 0; r < 16; ++r) {
            const int row = g.row0 + wm * 64 + mi * 32 + (r & 3) + 8 * (r >> 2) + 4 * hh;
            if (EPI == E_GU) {
                const float a = acc[mi][0][r], b = acc[mi][1][r];
                const int ac = ((g.col0 + wn * 64) >> 1) + l31;
                ((bf16_t*)(p.ws + OFF_act))[(size_t)row * DFF + ac] = f2bf(a / (1.f + __expf(-a)) * b);
            } else {
#pragma unroll
                for (int ni = 0; ni < 2; ++ni) {
                    const int col = g.col0 + wn * 64 + ni * 32 + l31;
                    const float v = acc[mi][ni][r];
                    if (EPI == E_IN) {
                        ((float*)(p.ws + OFF_P))[(size_t)row * NPR + col] = v;
                    } else if (EPI == E_BR) {
                        ((bf16_t*)(p.ws + OFF_merged))[(size_t)row * DM + col] = f2bf(tot[mi][ni][r]);
                    } else if (EPI == E_RES) {
                        const float gm = ((float*)(p.ws + OFF_mod))[(size_t)(g.layer * 3 + condrow(row)) * 6144 + (g.aux & 7) * DM + col];
                        __attribute__((address_space(1))) float* o = p.out + (size_t)row * DM + col;
                        if (!(g.aux & 8)) *o = *o + gm * v;
                    } else if (EPI == E_POOL) {
                        ((bf16_t*)(p.ws + OFF_br))[wtile_off(row, 1536 + g.aux * 128 + col, 2048)] = f2bf(v * p.pool_scale[g.layer * 512 + g.aux * 128 + col]);
                    }
                }
            }
        }
}

template <int EPI> DI void gemm_phase(const Ctx& cx, const Params& p, int layer, const bf16_t* A, int lda, const bf16_t* Bt, int ldb, int K, int N, int aux, unsigned char* smem) {
    const int nM = NTOK / 128, nN = N / 128;
    const int x = cx.bid & 7, j = cx.bid >> 3, J = gridDim.x >> 3;
    GemmArgs g; g.A = A; g.lda = lda; g.Bt = Bt; g.ldb = ldb; g.K = K; g.layer = layer; g.aux = aux; g.atk = K >> 5;
    if (nN == 8) {
        for (int t = j; t < (nM / 8) * 8; t += J) {
            g.row0 = ((t >> 3) * 8 + x) * 128; g.col0 = (t & 7) * 128;
            gemm_tile<EPI>(cx, p, g, smem, false, false, g);
        }
        return;
    }
    const int SN = J >> 3;
    const int nSM = nM / 8, nSN = (nN + SN - 1) / SN;
    GemmArgs gnx = g;
    int st = x; bool have = false;
    for (; st < nSM * nSN; st += 8) { const int pn = (st / nSM) * SN + (j >> 3); if (pn < nN) { g.row0 = ((st % nSM) * 8 + (j & 7)) * 128; g.col0 = pn * 128; have = true; st += 8; break; } }
    bool pre = false;
    while (have) {
        bool hn = false;
        for (; st < nSM * nSN; st += 8) { const int pn = (st / nSM) * SN + (j >> 3); if (pn < nN) { gnx.row0 = ((st % nSM) * 8 + (j & 7)) * 128; gnx.col0 = pn * 128; hn = true; st += 8; break; } }
        gemm_tile<EPI>(cx, p, g, smem, pre, hn, gnx);
        pre = hn; have = hn; g.row0 = gnx.row0; g.col0 = gnx.col0;
    }
}

DI void post_vunit(const Ctx& cx, const Params& p, int layer, int vt) {
    const int tid = cx.tid; const int pc = tid & 63, which = (tid >> 6) & 1, th = tid >> 7, col = 2 * pc;
    const int r0 = vt * 64 + th * 32;
    const bf16_t* src = ((bf16_t*)(p.ws + OFF_P)) + (size_t)r0 * NPR + (which ? 1408 : 640) + col;
    bf16_t* dst; size_t dstride; __attribute__((address_space(1))) float* of = nullptr;
    if (r0 < NCTX) { const int b = r0 >> 8, t0 = r0 & 255;
        dst = (which ? ((bf16_t*)(p.ws + OFF_vCcT)) : ((bf16_t*)(p.ws + OFF_vAcT))) + ((size_t)(b * 128 + col)) * 256 + t0; dstride = 256;
        of = p.out + (which ? OUT_VW : OUT_VA) + ((size_t)((b * 4 + layer) * 256 + t0)) * 128 + col;
    } else { const int b = (r0 - NCTX) >> 10, t0 = (r0 - NCTX) & 1023;
        dst = (which ? ((bf16_t*)(p.ws + OFF_vClT)) : ((bf16_t*)(p.ws + OFF_vAlT))) + ((size_t)((layer * 2 + b) * 128 + col)) * 1536 + 512 + t0; dstride = 1536;
    }
    unsigned raw[32];
#pragma unroll
    for (int j = 0; j < 32; ++j) raw[j] = __builtin_nontemporal_load((const unsigned*)(src + (size_t)j * NPR));
    __builtin_amdgcn_sched_barrier(0);
    if (of) {
#pragma unroll
        for (int j = 0; j < 32; ++j) {
            typedef float f32x2 __attribute__((ext_vector_type(2)));
            __builtin_nontemporal_store((f32x2){__uint_as_float(raw[j] << 16), __uint_as_float(raw[j] & 0xffff0000u)}, (__attribute__((address_space(1))) f32x2*)(of + (size_t)j * 128));
        }
    }
#pragma unroll
    for (int jc = 0; jc < 4; ++jc) {
        unsigned lo[4], hi[4];
#pragma unroll
        for (int q = 0; q < 4; ++q) {
            const unsigned a = raw[jc * 8 + 2 * q], b2 = raw[jc * 8 + 2 * q + 1];
            lo[q] = (a & 0xffffu) | (b2 << 16);
            hi[q] = (a >> 16) | (b2 & 0xffff0000u);
        }
        *(u32x4*)(dst + jc * 8) = (u32x4){lo[0], lo[1], lo[2], lo[3]};
        *(u32x4*)(dst + dstride + jc * 8) = (u32x4){hi[0], hi[1], hi[2], hi[3]};
    }
}

DI void post_row(const Ctx& cx, const Params& p, int layer, int r) {
    const int lane = cx.tid & 63;
    const bf16_t* Pr = ((bf16_t*)(p.ws + OFF_P)) + (size_t)r * NPR;
    const bool lat = r >= NCTX;
    int b, t, T;
    if (lat) { b = (r - NCTX) >> 10; t = (r - NCTX) & 1023; T = 1024; } else { b = r >> 8; t = r & 255; T = 256; }
    const int lh = lane & 31;
    unsigned hraw[10];
#pragma unroll
    for (int hp = 0; hp < 10; ++hp) {
        const int col = hp < 4 ? hp * 128 : hp == 4 ? 512 : hp < 9 ? 768 + (hp - 5) * 128 : 1280;
        hraw[hp] = __builtin_nontemporal_load((const unsigned*)(Pr + col + 2 * lane));
    }
    float cs[2] = {1.f, 1.f}, sn[2] = {0.f, 0.f};
    if (lat) {
        const float* rp = (float*)(p.ws + OFF_rope);
        const int pos = (lh < 16) ? (t >> 6) : (t & 63); const int i0 = (2 * lh) & 15;
        cs[0] = rp[pos * 16 + i0]; cs[1] = rp[pos * 16 + i0 + 1]; sn[0] = rp[1024 + pos * 16 + i0]; sn[1] = rp[1024 + pos * 16 + i0 + 1];
        if (!(lh & 8)) { sn[0] = -sn[0]; sn[1] = -sn[1]; }
    }
    float gsel4[4][2];
    gsel4[0][0] = p.gq_a[layer * 64 + 2 * lh]; gsel4[0][1] = p.gq_a[layer * 64 + 2 * lh + 1];
    gsel4[1][0] = p.gk_a[layer * 64 + 2 * lh]; gsel4[1][1] = p.gk_a[layer * 64 + 2 * lh + 1];
    gsel4[2][0] = p.gq_c[layer * 64 + 2 * lh]; gsel4[2][1] = p.gq_c[layer * 64 + 2 * lh + 1];
    gsel4[3][0] = p.gk_c[layer * 64 + 2 * lh]; gsel4[3][1] = p.gk_c[layer * 64 + 2 * lh + 1];
#pragma unroll
    for (int hp = 0; hp < 10; ++hp) {
        const int typ = hp < 4 ? 0 : hp == 4 ? 1 : hp < 9 ? 2 : 3;
        const bool isk = typ & 1; const int which = typ >> 1;
        const float v0 = __uint_as_float(hraw[hp] << 16), v1 = __uint_as_float(hraw[hp] & 0xffff0000u);
        float ss = v0 * v0 + v1 * v1;
#pragma unroll
        for (int o = 16; o >= 1; o >>= 1) ss += __shfl_xor(ss, o);
        const float rn = rsqrtf(ss * (1.0f / 64.f) + 1e-6f);
        float y0 = v0 * rn * gsel4[typ][0], y1 = v1 * rn * gsel4[typ][1];
        if (lat) { const float p0 = __shfl_xor(y0, 8), p1 = __shfl_xor(y1, 8); y0 = y0 * cs[0] + p0 * sn[0]; y1 = y1 * cs[1] + p1 * sn[1]; }
        if (!isk) {
            const int qh0 = (which ? hp - 5 : hp) * 2;
            *(unsigned*)(((bf16_t*)(p.ws + (which ? OFF_qC : OFF_qA))) + (size_t)r * 512 + qh0 * 64 + 2 * lane) = pack2(y0 * QSCALE, y1 * QSCALE);
        } else if (!lat) {
            *(unsigned*)(((bf16_t*)(p.ws + (which ? OFF_kCc : OFF_kAc))) + (size_t)r * 128 + 2 * lane) = pack2(y0, y1);
            __attribute__((address_space(1))) float* ok = p.out + (which ? OUT_KW : OUT_KA) + ((size_t)((b * 4 + layer) * 256 + t)) * 128 + 2 * lane;
            __builtin_nontemporal_store(y0, ok); __builtin_nontemporal_store(y1, ok + 1);
        } else {
            *(unsigned*)(((bf16_t*)(p.ws + (which ? OFF_kCl : OFF_kAl))) + ((size_t)((layer * 2 + b) * 1536 + 512 + t)) * 128 + 2 * lane) = pack2(y0, y1);
        }
    }
    asm volatile("" ::: "memory");
    const float mm = (t > 0) ? 1.f : 0.f, mp = (t < T - 1) ? 1.f : 0.f;
    const bf16_t* Pm = Pr - ((t > 0) ? NPR : 0);
    const bf16_t* Pp = Pr + ((t < T - 1) ? NPR : 0);
    const float* cw = p.conv_w + layer * 3 * 512;
#pragma unroll
    for (int half = 0; half < 2; ++half) {
        float yc[2][2], ym[2][2];
#pragma unroll
        for (int ii = 0; ii < 2; ++ii) {
            const int i = half * 2 + ii;
            const int c = i * 128 + 2 * lane;
            const unsigned gc0 = *(const unsigned*)(Pr + 2560 + c), u0 = *(const unsigned*)(Pr + 1536 + c);
            const unsigned gcm = *(const unsigned*)(Pm + 2560 + c), um = *(const unsigned*)(Pm + 1536 + c);
            const unsigned gcp = *(const unsigned*)(Pp + 2560 + c), up = *(const unsigned*)(Pp + 1536 + c);
            const unsigned gb = __builtin_nontemporal_load((const unsigned*)(Pr + 2048 + c));
            const float w0[2] = {cw[c], cw[c + 1]}, w1[2] = {cw[512 + c], cw[512 + c + 1]}, w2[2] = {cw[1024 + c], cw[1024 + c + 1]};
            const int hw = 1 << i;
            int lo = t - hw; lo = lo < 0 ? 0 : lo;
            int hi = t + hw; hi = hi > T ? T : hi;
            float sacc[2] = {0.f, 0.f}; unsigned pf = 0u;
#pragma unroll
            for (int q = -hw; q < hw; ++q) {
                const int tq = t + q; const bool ok = tq >= 0 && tq < T;
                const int dq = ok ? q : 0;
                const unsigned w = *(const unsigned*)(Pr + (ptrdiff_t)dq * NPR + 3072 + c);
                const float okf = ok ? 1.f : 0.f;
                sacc[0] += __uint_as_float(w << 16) * okf; sacc[1] += __uint_as_float(w & 0xffff0000u) * okf;
                if (q == 0) pf = w;
            }
            const float rn = 1.0f / (float)(hi - lo);
#pragma unroll
            for (int e = 0; e < 2; ++e) {
                auto sel = [&](unsigned w) { return e ? __uint_as_float(w & 0xffff0000u) : __uint_as_float(w << 16); };
                const float z0 = sel(gc0) * sel(u0), zm = sel(gcm) * sel(um) * mm, zp = sel(gcp) * sel(up) * mp;
                yc[ii][e] = sel(gb) * (zm * w0[e] + z0 * w1[e] + zp * w2[e]);
                ym[ii][e] = sacc[e] * rn - sel(pf);
            }
        }
#pragma unroll
        for (int ii = 0; ii < 2; ++ii) {
            const int c = (half * 2 + ii) * 128 + 2 * lane;
            *(unsigned*)(((bf16_t*)(p.ws + OFF_br)) + wtile_off(r, 512 + c, 2048)) = pack2(yc[ii][0], yc[ii][1]);
            *(unsigned*)(((bf16_t*)(p.ws + OFF_ypool)) + (size_t)r * 512 + c) = pack2(ym[ii][0], ym[ii][1]);
        }
        asm volatile("" ::: "memory");
    }
}

constexpr int KSTR = 72, VSTR = 68;
constexpr int ATT_BUF_E = 64 * KSTR + 64 * VSTR;
DI void attn_unit(const Ctx& cx, const Params& p, int layer, int kind, int b, int head, int qb, unsigned char* smem) {
    const int tid = cx.tid, wid = tid >> 6, lane = tid & 63, ql = lane & 31, hh = lane >> 5;
    const bool isC = kind & 1, isLat = kind >= 2;
    const int kvh = head >> 2;
    const int qrow = (isLat ? NCTX + b * 1024 : b * 256) + qb * 128 + wid * 32 + ql;
    const bf16_t* Kp; const bf16_t* Vt; int S;
    if (!isLat) { S = 256; Kp = (isC ? ((bf16_t*)(p.ws + OFF_kCc)) : ((bf16_t*)(p.ws + OFF_kAc))) + (size_t)b * 256 * 128 + kvh * 64; Vt = (isC ? ((bf16_t*)(p.ws + OFF_vCcT)) : ((bf16_t*)(p.ws + OFF_vAcT))) + (size_t)((b * 2 + kvh) * 64) * 256; }
    else { S = 1536; Kp = (isC ? ((bf16_t*)(p.ws + OFF_kCl)) : ((bf16_t*)(p.ws + OFF_kAl))) + (size_t)((layer * 2 + b) * 1536) * 128 + kvh * 64; Vt = (isC ? ((bf16_t*)(p.ws + OFF_vClT)) : ((bf16_t*)(p.ws + OFF_vAlT))) + (size_t)(((layer * 2 + b) * 2 + kvh) * 64) * 1536; }
    int nt1 = S / 64, t2lo = 0, t2hi = 0;
    if (kind == 3) { nt1 = 8; const int i0 = qb * 128; const int jlo = i0 - 128 < 0 ? 0 : i0 - 128; const int jhi = i0 + 256 > 1024 ? 1024 : i0 + 256; t2lo = 8 + (jlo >> 6); t2hi = 8 + (jhi >> 6); }
    const int ntiles = nt1 + (t2hi - t2lo);
    bf16x8 qf[4];
    { const bf16_t* q = (isC ? ((bf16_t*)(p.ws + OFF_qC)) : ((bf16_t*)(p.ws + OFF_qA))) + (size_t)qrow * 512 + head * 64 + hh * 8;
#pragma unroll
      for (int ks = 0; ks < 4; ++ks) qf[ks] = *(const bf16x8*)(q + ks * 16); }
    bf16_t* L = (bf16_t*)smem;
    const int sr = tid >> 3, scc = (tid & 7) * 8;
    u32x4 rk[2], rv[2];
    auto gload = [&](int it) {
        const int kt = it < nt1 ? it : t2lo + (it - nt1);
#pragma unroll
        for (int i = 0; i < 2; ++i) {
            rk[i] = *(const u32x4*)(Kp + (size_t)(kt * 64 + sr + 32 * i) * 128 + scc);
            rv[i] = *(const u32x4*)(Vt + (size_t)(sr + 32 * i) * S + kt * 64 + scc);
        }
    };
    auto lstore = [&](int buf) {
        bf16_t* Ks = L + buf * ATT_BUF_E; bf16_t* Vs = Ks + 64 * KSTR;
#pragma unroll
        for (int i = 0; i < 2; ++i) {
            *(u32x4*)(Ks + (sr + 32 * i) * KSTR + scc) = rk[i];
            u32x2* vd = (u32x2*)(Vs + (sr + 32 * i) * VSTR + scc);
            vd[0] = (u32x2){rv[i][0], rv[i][1]}; vd[1] = (u32x2){rv[i][2], rv[i][3]};
        }
    };
    f32x16 ot[2];
#pragma unroll
    for (int r = 0; r < 16; ++r) { ot[0][r] = 0.f; ot[1][r] = 0.f; }
    float m = -1e30f, lsum = 0.f;
    const int qpos = qb * 128 + wid * 32 + ql;
    gload(0); lstore(0); __syncthreads();
    for (int it = 0; it < ntiles; ++it) {
        const int buf = it & 1;
        if (it + 1 < ntiles) gload(it + 1);
        const bf16_t* Ks = L + buf * ATT_BUF_E; const bf16_t* Vs = Ks + 64 * KSTR;
        f32x16 st[2];
#pragma unroll
        for (int j = 0; j < 2; ++j) {
#pragma unroll
            for (int r = 0; r < 16; ++r) st[j][r] = 0.f;
#pragma unroll
            for (int ks = 0; ks < 4; ++ks) {
                const bf16x8 a = *(const bf16x8*)(Ks + (j * 32 + ql) * KSTR + ks * 16 + hh * 8);
                st[j] = __builtin_amdgcn_mfma_f32_32x32x16_bf16(a, qf[ks], st[j], 0, 0, 0);
            }
        }
        if (kind == 3 && it >= nt1) {
            const int kt = t2lo + (it - nt1);
            const int jbase = kt * 64 - 512;
#pragma unroll
            for (int j = 0; j < 2; ++j)
#pragma unroll
                for (int r = 0; r < 16; ++r) {
                    const int jp = jbase + j * 32 + (r & 3) + 8 * (r >> 2) + 4 * hh;
                    const int d = qpos - jp;
                    if (d > 128 || d < -128) st[j][r] = -1e30f;
                }
        }
        float mx = st[0][0];
#pragma unroll
        for (int j = 0; j < 2; ++j)
#pragma unroll
            for (int r = 0; r < 16; ++r) mx = fmaxf(mx, st[j][r]);
        mx = fmaxf(mx, __shfl_xor(mx, 32));
        const float mn = fmaxf(m, mx);
        const float alpha = __builtin_amdgcn_exp2f(m - mn);
        m = mn;
        float ps = 0.f;
#pragma unroll
        for (int j = 0; j < 2; ++j)
#pragma unroll
            for (int r = 0; r < 16; ++r) { const float e = __builtin_amdgcn_exp2f(st[j][r] - mn); st[j][r] = e; ps += e; }
        lsum = lsum * alpha + ps;
#pragma unroll
        for (int r = 0; r < 16; ++r) { ot[0][r] *= alpha; ot[1][r] *= alpha; }
#pragma unroll
        for (int j = 0; j < 2; ++j)
#pragma unroll
            for (int s2 = 0; s2 < 2; ++s2) {
                const u32x4 pw = (u32x4){pack2(st[j][8 * s2 + 0], st[j][8 * s2 + 1]), pack2(st[j][8 * s2 + 2], st[j][8 * s2 + 3]),
                                         pack2(st[j][8 * s2 + 4], st[j][8 * s2 + 5]), pack2(st[j][8 * s2 + 6], st[j][8 * s2 + 7])};
                const bf16x8 pf = __builtin_bit_cast(bf16x8, pw);
#pragma unroll
                for (int db = 0; db < 2; ++db) {
                    const bf16_t* vp = Vs + (db * 32 + ql) * VSTR + j * 32 + s2 * 16 + 4 * hh;
                    const s16x4 lo = *(const s16x4*)vp, hi = *(const s16x4*)(vp + 8);
                    const bf16x8 vf = __builtin_shufflevector(lo, hi, 0, 1, 2, 3, 4, 5, 6, 7);
                    ot[db] = __builtin_amdgcn_mfma_f32_32x32x16_bf16(vf, pf, ot[db], 0, 0, 0);
                }
            }
        if (it + 1 < ntiles) lstore(buf ^ 1);
        __syncthreads();
    }
    float lt = lsum + __shfl_xor(lsum, 32);
    float oscale = 1.f;
    if (isC) {
        const float sk = p.sink[layer * 8 + head] * LOG2E;
        const float mf = fmaxf(m, sk);
        oscale = __builtin_amdgcn_exp2f(m - mf);
        lt = lt * oscale + __builtin_amdgcn_exp2f(sk - mf);
    }
    const float inv = oscale / lt;
    bf16_t* o = ((bf16_t*)(p.ws + OFF_br)) + wtile_off(qrow, (isC ? 1024 : 0) + head * 64, 2048);
#pragma unroll
    for (int db = 0; db < 2; ++db)
#pragma unroll
        for (int g4 = 0; g4 < 4; ++g4) {
            const int d = db * 32 + 8 * g4 + 4 * hh;
            *(u32x2*)(o + db * 4096 + 8 * g4 + 4 * hh) = (u32x2){pack2(ot[db][4 * g4 + 0] * inv, ot[db][4 * g4 + 1] * inv), pack2(ot[db][4 * g4 + 2] * inv, ot[db][4 * g4 + 3] * inv)};
        }
}

DI void idle_transposes(const Ctx& cx, const Params& p, int layer, int part, unsigned char* smem) {
    if (layer + 1 >= NL) return;
    const int lo = part == 1 ? 0 : part == 2 ? 1640 : 2510, hi = part == 1 ? 1640 : part == 2 ? 2510 : 4816;
    unsigned* qctr = (unsigned*)(p.ws + OFF_bar) + 3856 + (layer * 4 + part) * 8;
    volatile unsigned* slot = (volatile unsigned*)(smem + 73696);
    for (;;) {
        __syncthreads();
        if (cx.tid == 0) *slot = atomicAdd(qctr, 1u);
        __syncthreads();
        const int t = (int)*slot;
        if (t >= hi - lo) break;
        prologue_transpose(cx, p, (layer + 1) * 4816 + lo + t, smem);
    }
}

DI void run_phase(const Ctx& cx, const Params& p, int ph, unsigned char* smem, int dry) {
    const int tid = cx.tid, wid = tid >> 6;
    if (ph < 2) {
        const int total = ph == 0 ? PRO_MOD + PRO_MISC + 1488 : 3328 + 512;
        for (int u = cx.bid; u < total; u += gridDim.x) {
            int ti = -1;
            if (ph == 0) {
                if (u < PRO_MOD) prologue_mod(cx, p, u, smem);
                else if (u < PRO_MOD + PRO_MISC) prologue_misc(cx, p, u - PRO_MOD);
                else { const int i = u - PRO_MOD - PRO_MISC; ti = i < 768 ? 1920 + i : 4096 + (i - 768); }
            } else {
                if (u < 3328) ti = u < 1920 ? u : 2688 + (u - 1920);
                else x0_rows(cx, p, (u - 3328) * 4 + wid, 2048);
            }
            if (ti >= 0) prologue_transpose(cx, p, ti, smem);
        }
        return;
    }
    const int layer = (ph - 2) / 7, sub = (ph - 2) % 7;
    switch (sub) {
    case 0: gemm_phase<E_IN>(cx, p, layer, ((bf16_t*)(p.ws + OFF_h)), DM, ((bf16_t*)(p.ws + OFF_WinT)) + (size_t)layer * NIN * DM, DM, DM, NPR, 0, smem); break;
    case 1: for (int u = cx.bid; u < 96 + 1536; u += gridDim.x) { if (u < 96) post_vunit(cx, p, layer, u); else post_row(cx, p, layer, (u - 96) * 4 + wid); } break;
    case 2:
        for (int u = cx.bid; u < 960; u += gridDim.x) {
            if (u < 128) attn_unit(cx, p, layer, 2, u >> 6, (u >> 3) & 7, u & 7, smem);
            else if (u < 256) { const int v = u - 128; attn_unit(cx, p, layer, 3, v >> 6, (v >> 3) & 7, v & 7, smem); }
            else if (u < 512) { const int v = u - 256; attn_unit(cx, p, layer, 0, v >> 4, (v >> 1) & 7, v & 1, smem); }
            else if (u < 768) { const int v = u - 512; attn_unit(cx, p, layer, 1, v >> 4, (v >> 1) & 7, v & 1, smem); }
            else { const int v = u - 768; const int pm = v >> 2, grp = v & 3;
                GemmArgs g; g.A = ((bf16_t*)(p.ws + OFF_ypool)) + grp * 128; g.lda = 512; g.Bt = ((bf16_t*)(p.ws + OFF_PoolT)) + (size_t)(layer * 4 + grp) * 16384; g.ldb = 128; g.K = 128; g.row0 = pm * 128; g.col0 = 0; g.layer = layer; g.aux = grp; g.atk = 0;
                gemm_tile<E_POOL>(cx, p, g, smem, false, false, g); }
        }
        if (!dry) {
            unsigned* qctr = (unsigned*)(p.ws + OFF_bar) + 3600 + (layer * 2 + dry) * 32;
            volatile unsigned* slot = (volatile unsigned*)(smem + 73696);
            GemmArgs g, gnx; g.A = (bf16_t*)(p.ws + OFF_h); g.lda = DM; g.Bt = ((bf16_t*)(p.ws + OFF_WinT)) + (size_t)layer * NIN * DM; g.ldb = DM; g.K = DM; g.layer = layer; g.aux = 0; g.atk = DM >> 5;
            gnx = g;
            __syncthreads();
            if (tid == 0) *slot = atomicAdd(qctr, 1u);
            __syncthreads();
            unsigned t = *slot; bool pre = false;
            while (t < 1536u) {
                __syncthreads();
                if (tid == 0) *slot = atomicAdd(qctr, 1u);
                __syncthreads();
                const unsigned tn = *slot;
                g.row0 = (int)(t % 48u) * 128; g.col0 = NPR + (int)(t / 48u) * 128;
                const bool hn = tn < 1536u;
                if (hn) { gnx.row0 = (int)(tn % 48u) * 128; gnx.col0 = NPR + (int)(tn / 48u) * 128; }
                gemm_tile<E_IN>(cx, p, g, smem, pre, hn, gnx);
                pre = hn; t = tn;
            }
        }
        break;
    case 3: gemm_phase<E_BR>(cx, p, layer, ((bf16_t*)(p.ws + OFF_br)), 2048, ((bf16_t*)(p.ws + OFF_WbrT)) + (size_t)layer * DM * 2048, 2048, 2048, DM, 0, smem); break;
    case 4: gemm_phase<E_RES>(cx, p, layer, ((bf16_t*)(p.ws + OFF_merged)), DM, ((bf16_t*)(p.ws + OFF_WoT)) + (size_t)layer * DM * DM, DM, DM, DM, 2, smem); break;
    case 5: gemm_phase<E_GU>(cx, p, layer, ((bf16_t*)(p.ws + OFF_h)), DM, ((bf16_t*)(p.ws + OFF_WguT)) + (size_t)layer * 2 * DFF * DM, DM, DM, 2 * DFF, 0, smem); break;
    case 6: gemm_phase<E_RES>(cx, p, layer, ((bf16_t*)(p.ws + OFF_act)), DFF, ((bf16_t*)(p.ws + OFF_WdT)) + (size_t)layer * DM * DFF, DFF, DFF, DM, 5, smem); break;
    }
    if (sub == 3 || sub == 4 || sub == 6) idle_transposes(cx, p, layer, sub == 3 ? 1 : sub == 4 ? 2 : 3, smem);
}

__global__ void __launch_bounds__(256, 2) fwd_megakernel(Params p) {
    __shared__ __attribute__((aligned(16))) unsigned char smem[73728];
#if MK_MULTI
    Ctx cx; cx.tid = threadIdx.x; cx.bid = blockIdx.x;
    run_phase(cx, p, p.phase_lo, smem, 0);
#else
    if (threadIdx.x == 0) *(uint4*)(smem + 73712) = make_uint4(0u, 0u, 0u, 0u);
    __syncthreads();
    XcdBarrier xb = xcd_barrier_post((unsigned*)(p.ws + OFF_bar), (volatile LAS unsigned*)(smem + 73712));
    if (p.phase_lo < 0) cg::this_grid().sync();
    for (int ph = p.phase_lo; ph < p.phase_hi; ++ph) {
        Ctx cx; cx.tid = threadIdx.x; cx.bid = blockIdx.x;
        asm volatile("" : "+v"(cx.tid));
        asm volatile("" : "+s"(cx.bid));
        Params q = p;
        asm volatile("" : "+s"(q.ws));
        asm volatile("" : "+s"(q.out));
        run_phase(cx, q, ph, smem, 0);
        if (ph + 1 < p.phase_hi) xcd_barrier(xb);
#if PROBE2
        if (ph >= 2) { const int sub = (ph - 2) % 7;
            if (((PROBE2 & 1) && sub == 0) || ((PROBE2 & 2) && sub == 1) || ((PROBE2 & 8) && sub == 5)) { run_phase(cx, q, ph, smem, 0); xcd_barrier(xb); }
            if ((PROBE2 & 4) && sub == 1) { run_phase(cx, q, ph + 1, smem, 1); xcd_barrier(xb); } }
#endif
    }
#endif
}

extern "C" void kernel_launch(void* const* d_in, const int* in_sizes, int n_in, void* d_out, int out_size, void* d_ws, size_t ws_size, hipStream_t stream) {
    Params p; memset(&p, 0, sizeof(p));
    const float* const* in = (const float* const*)d_in;
    p.x_prompt = in[0]; p.x_sample = in[1]; p.ck_a = in[2]; p.cv_a = in[3]; p.ck_w = in[4]; p.cv_w = in[5]; p.c = in[6]; p.c_ctx = in[7];
    p.w_mod = in[8]; p.b_mod = in[9]; p.g_mix = in[10]; p.g_ffn = in[11]; p.w_in = in[12]; p.gq_a = in[13]; p.gk_a = in[14]; p.gq_c = in[15]; p.gk_c = in[16];
    p.sink = in[17]; p.conv_w = in[18]; p.pool_w = in[19]; p.pool_scale = in[20]; p.w_br = in[21]; p.w_o = in[22]; p.w_gu = in[23]; p.w_down = in[24];
    p.out = (__attribute__((address_space(1))) float*)d_out;
    p.ws = (__attribute__((address_space(1))) unsigned char*)d_ws;
    if (WS_TOTAL > ws_size) { fprintf(stderr, "workspace too small: need %zu have %zu\n", (size_t)WS_TOTAL, ws_size); return; }
#if MK_MULTI
    for (int ph = 0; ph < NPHASE; ++ph) {
        p.phase_lo = ph; p.phase_hi = ph + 1;
        hipLaunchKernelGGL(fwd_megakernel, dim3(512), dim3(256), 0, stream, p);
    }
#else
    static int grid_blocks = 0;
    if (!grid_blocks) {
        int dev = 0, cus = 0, per_cu = 0;
        hipGetDevice(&dev);
        hipDeviceGetAttribute(&cus, hipDeviceAttributeMultiprocessorCount, dev);
        hipOccupancyMaxActiveBlocksPerMultiprocessor(&per_cu, fwd_megakernel, 256, 0);
        if (per_cu > 2) per_cu = 2;
        if (per_cu < 1) per_cu = 1;
        grid_blocks = cus * per_cu;
    }
    p.phase_lo = 0; p.phase_hi = NPHASE;
    (void)hipMemsetAsync((unsigned char*)d_ws + OFF_bar, 0, 16384, stream);
    void* args[] = {&p};
    hipError_t e = hipLaunchCooperativeKernel((void*)fwd_megakernel, dim3(grid_blocks), dim3(256), args, 0, stream);
    if (e != hipSuccess) fprintf(stderr, "cooperative launch failed: %s (grid %d)\n", hipGetErrorString(e), grid_blocks);
#endif
}
```

```cpp
#include <hip/hip_runtime.h>
#include <hip/hip_cooperative_groups.h>
#include <cstdio>
#include <cstdint>
#include <cstring>
namespace cg = cooperative_groups;

#ifndef PROBE2
#define PROBE2 0
#endif
#ifndef PROBE_REP
#define PROBE_REP 0
#endif
#ifndef PROBE_DRYBITS
#define PROBE_DRYBITS 8
#endif
#ifndef MK_MULTI
#define MK_MULTI 0
#endif

typedef unsigned short bf16_t;
typedef short bf16x8 __attribute__((ext_vector_type(8)));
typedef short s16x4 __attribute__((ext_vector_type(4)));
typedef float f32x16 __attribute__((ext_vector_type(16)));
typedef float f32x4 __attribute__((ext_vector_type(4)));
typedef unsigned u32x4 __attribute__((ext_vector_type(4)));
typedef unsigned u32x2 __attribute__((ext_vector_type(2)));
#define DI __device__ __forceinline__
#define LAS __attribute__((address_space(3)))

constexpr int NTOK = 6144, NCTX = 4096, DM = 1024, NIN = 7680, NPR = 3584, DFF = 2816, NL = 4;
constexpr float LOG2E = 1.4426950408889634f;
constexpr float QSCALE = 0.125f * LOG2E;
constexpr size_t OUT_KA = 6291456, OUT_VA = 8388608, OUT_KW = 10485760, OUT_VW = 12582912;
constexpr int NPHASE = 2 + 7 * NL;
constexpr float SSQ_SCALE = 256.f, SSQ_INV = 1.0f / 256.f, BIAS_SCALE = 16777216.f, BIAS_INV = 1.0f / 16777216.f;
constexpr int NBIAS = NIN + 2 * DFF;

constexpr size_t al256(size_t x) { return (x + 255) & ~(size_t)255; }
constexpr size_t OFF_bar = 0;
constexpr size_t OFF_mod = OFF_bar + al256(16384);
constexpr size_t OFF_rope = OFF_mod + al256((size_t)NL * 3 * 6144 * 4);
constexpr size_t OFF_WinT = OFF_rope + al256(2048 * 4);
constexpr size_t OFF_WbrT = OFF_WinT + al256((size_t)NL * NIN * DM * 2);
constexpr size_t OFF_WoT = OFF_WbrT + al256((size_t)NL * DM * 2048 * 2);
constexpr size_t OFF_WguT = OFF_WoT + al256((size_t)NL * DM * DM * 2);
constexpr size_t OFF_WdT = OFF_WguT + al256((size_t)NL * 2 * DFF * DM * 2);
constexpr size_t OFF_PoolT = OFF_WdT + al256((size_t)NL * DM * DFF * 2);
constexpr size_t OFF_h = OFF_PoolT + al256((size_t)NL * 4 * 128 * 128 * 2);
constexpr size_t OFF_P = OFF_h + al256((size_t)NTOK * DM * 2);
constexpr size_t OFF_gates = OFF_P + al256((size_t)NTOK * NPR * 4);
constexpr size_t OFF_qA = OFF_gates + al256((size_t)NTOK * 4096 * 2);
constexpr size_t OFF_qC = OFF_qA + al256((size_t)NTOK * 512 * 2);
constexpr size_t OFF_kAc = OFF_qC + al256((size_t)NTOK * 512 * 2);
constexpr size_t OFF_kCc = OFF_kAc + al256((size_t)NCTX * 128 * 2);
constexpr size_t OFF_kAl = OFF_kCc + al256((size_t)NCTX * 128 * 2);
constexpr size_t OFF_kCl = OFF_kAl + al256((size_t)NL * 2 * 1536 * 128 * 2);
constexpr size_t OFF_vAcT = OFF_kCl + al256((size_t)NL * 2 * 1536 * 128 * 2);
constexpr size_t OFF_vCcT = OFF_vAcT + al256((size_t)NCTX * 128 * 2);
constexpr size_t OFF_vAlT = OFF_vCcT + al256((size_t)NCTX * 128 * 2);
constexpr size_t OFF_vClT = OFF_vAlT + al256((size_t)NL * 2 * 1536 * 128 * 2);
constexpr size_t OFF_ypool = OFF_vClT + al256((size_t)NL * 2 * 1536 * 128 * 2);
constexpr size_t OFF_br = OFF_ypool + al256((size_t)NTOK * 512 * 2);
constexpr size_t OFF_merged = OFF_br + al256((size_t)NTOK * 2048 * 2);
constexpr size_t OFF_act = OFF_merged + al256((size_t)NTOK * DM * 2);
constexpr size_t OFF_ssq = OFF_act + al256((size_t)NTOK * DFF * 2);
constexpr size_t OFF_bias = OFF_ssq + al256((size_t)NL * 2 * NTOK * 4);
constexpr size_t WS_TOTAL = OFF_bias + al256((size_t)NL * 3 * NBIAS * 4);

struct Ctx { int tid, bid; };
struct Params {
    const float *x_prompt, *x_sample, *ck_a, *cv_a, *ck_w, *cv_w, *c, *c_ctx;
    const float *w_mod, *b_mod, *g_mix, *g_ffn, *w_in, *gq_a, *gk_a, *gq_c, *gk_c, *sink, *conv_w, *pool_w, *pool_scale, *w_br, *w_o, *w_gu, *w_down;
    __attribute__((address_space(1))) float* out;
    __attribute__((address_space(1))) unsigned char* ws;
    int phase_lo, phase_hi;
};

DI bf16_t f2bf(float x) { return __builtin_bit_cast(unsigned short, (__bf16)x); }
DI float bf2f(bf16_t v) { return __uint_as_float(((unsigned)v) << 16); }
DI unsigned pack2(float lo, float hi) {
    typedef __bf16 bf2 __attribute__((ext_vector_type(2)));
    typedef float f2 __attribute__((ext_vector_type(2)));
    f2 x = {lo, hi};
    return __builtin_bit_cast(unsigned, __builtin_convertvector(x, bf2));
}
DI size_t wtile_off(int n, int k, int K) { return ((size_t)(n >> 7) * (K >> 5) + (k >> 5)) * 4096 + (n & 127) * 32 + (k & 31); }
DI float wave_sum(float v) {
#pragma unroll
    for (int o = 32; o >= 1; o >>= 1) v += __shfl_xor(v, o);
    return v;
}
DI float fsigmoid(float x) { return __builtin_amdgcn_rcpf(1.f + __builtin_amdgcn_exp2f(-LOG2E * x)); }
DI void sigmoid16(const f32x16& x, float (&o)[16]) {
#pragma unroll
    for (int r = 0; r < 16; ++r) o[r] = x[r] * (-LOG2E);
    __builtin_amdgcn_sched_barrier(0);
#pragma unroll
    for (int r = 0; r < 16; ++r) o[r] = __builtin_amdgcn_exp2f(o[r]);
    __builtin_amdgcn_sched_barrier(0);
#pragma unroll
    for (int r = 0; r < 16; ++r) o[r] = 1.f + o[r];
#pragma unroll
    for (int r = 0; r < 16; ++r) o[r] = __builtin_amdgcn_rcpf(o[r]);
    __builtin_amdgcn_sched_barrier(0);
}
DI int condrow(int r) { return r < NCTX ? 0 : 1 + ((r - NCTX) >> 10); }

#define XB_TMO      128
#define XB_XCNT(j)  (256  + 64 * (j))
#define XB_XSUB(j)  (1280 + 64 * (j))
#define XB_XGEN(j)  (2304 + 64 * (j))
#define XB_TOP      3328
#define XB_TOPGEN   3392
#define XCD_BAR_WORDS 3456
#define XB_SPIN_CAP (1u << 22)
DI unsigned xb_ld(unsigned* p) { return __hip_atomic_load(p, __ATOMIC_RELAXED, __HIP_MEMORY_SCOPE_AGENT); }
DI unsigned xb_add(unsigned* p, unsigned v) { return __hip_atomic_fetch_add(p, v, __ATOMIC_RELAXED, __HIP_MEMORY_SCOPE_AGENT); }
DI unsigned xb_xcc_id() { return (unsigned)__builtin_amdgcn_s_getreg((3 << 11) | 20) & 0xFu; }
#define XB_SPIN(cond, bar) do { unsigned _sp = 0; while (cond) { __builtin_amdgcn_s_sleep(1); \
    if ((++_sp & 255u) == 0u) { if (xb_ld(&(bar)[XB_TMO])) break; if (_sp > XB_SPIN_CAP) { atomicAdd(&(bar)[XB_TMO], 1u); break; } } } } while (0)
struct XcdBarrier { unsigned* bar; unsigned x; volatile LAS unsigned* st; };
DI XcdBarrier xcd_barrier_post(unsigned* bar, volatile LAS unsigned* st) {
    XcdBarrier b; b.bar = bar; b.x = xb_xcc_id(); b.st = st;
    if (threadIdx.x == 0) (void)xb_add(&bar[XB_XCNT(b.x)], 1u);
    return b;
}
DI void xcd_barrier_complete(unsigned* bar, unsigned x, unsigned& nloc, unsigned& nx) {
    const unsigned G = gridDim.x * gridDim.y * gridDim.z;
    unsigned sum, cnt, mine, sp = 0u;
    for (;;) {
        sum = 0u; cnt = 0u; mine = 0u;
#pragma unroll
        for (unsigned j = 0; j < 16; ++j) { const unsigned c = xb_ld(&bar[XB_XCNT(j)]); sum += c; cnt += (c > 0u) ? 1u : 0u; mine = (j == x) ? c : mine; }
        if (sum == G) break;
        __builtin_amdgcn_s_sleep(1);
        if ((++sp & 255u) == 0u) { if (xb_ld(&bar[XB_TMO])) break; if (sp > XB_SPIN_CAP) { atomicAdd(&bar[XB_TMO], 1u); break; } }
    }
    nloc = mine > 0u ? mine : 1u; nx = cnt > 0u ? cnt : 1u;
}
DI void xcd_barrier(const XcdBarrier& b) {
    asm volatile("s_waitcnt vmcnt(0)" ::: "memory");
    __syncthreads();
    if (threadIdx.x == 0) {
        unsigned* bar = b.bar;
        __builtin_amdgcn_s_waitcnt(0);
        unsigned nloc = b.st[0], nx = b.st[1];
        if (nloc == 0u) { xcd_barrier_complete(bar, b.x, nloc, nx); b.st[0] = nloc; b.st[1] = nx; }
        const unsigned old = xb_add(&bar[XB_XSUB(b.x)], 1u);
        const unsigned gen = old / nloc;
        if (old + 1u == (gen + 1u) * nloc) {
            __builtin_amdgcn_fence(__ATOMIC_RELEASE, "agent");
            asm volatile("s_waitcnt vmcnt(0)" ::: "memory");
            const unsigned og = xb_add(&bar[XB_TOP], 1u);
            const unsigned tg = og / nx;
            if (og + 1u == (tg + 1u) * nx) xb_add(&bar[XB_TOPGEN], 1u);
            else XB_SPIN(xb_ld(&bar[XB_TOPGEN]) == tg, bar);
            __builtin_amdgcn_fence(__ATOMIC_ACQUIRE, "agent");
            xb_add(&bar[XB_XGEN(b.x)], 1u);
            asm volatile("s_waitcnt vmcnt(0)" ::: "memory");
        } else {
            XB_SPIN(xb_ld(&bar[XB_XGEN(b.x)]) == gen, bar);
            __builtin_amdgcn_fence(__ATOMIC_ACQUIRE, "agent");
            asm volatile("s_waitcnt vmcnt(0)" ::: "memory");
        }
    }
    __syncthreads();
}

DI void transpose_tile(const Ctx& cx, const float* __restrict__ src, int ldsrc, int k0, int n0, bf16_t* __restrict__ dst, int ldd, int dcol0, int drow0, unsigned char* smem,
                       const float* shp = nullptr, float* biasp = nullptr) {
    float* T = (float*)smem;
    const int tid = cx.tid;
    const int kk = tid >> 4, c4 = (tid & 15) * 4;
    f32x4 v[4];
#pragma unroll
    for (int i = 0; i < 4; ++i) v[i] = __builtin_nontemporal_load((const f32x4*)(src + (size_t)(k0 + kk + 16 * i) * ldsrc + n0 + c4));
    __builtin_amdgcn_sched_barrier(0);
#pragma unroll
    for (int i = 0; i < 4; ++i) {
        float* t = T + (kk + 16 * i) * 65 + c4;
        t[0] = v[i][0]; t[1] = v[i][1]; t[2] = v[i][2]; t[3] = v[i][3];
    }
    float* SH = T + 64 * 65;
    if (shp && tid < 192) SH[tid] = shp[(tid >> 6) * 6144 + k0 + (tid & 63)];
    __syncthreads();
    const int nl = tid >> 2, kq = tid & 3;
    float tv[16];
#pragma unroll
    for (int j = 0; j < 16; ++j) tv[j] = T[(kq * 16 + j) * 65 + nl];
    unsigned w[8];
#pragma unroll
    for (int j = 0; j < 8; ++j) w[j] = pack2(tv[2 * j], tv[2 * j + 1]);
    bf16_t* d = dst + wtile_off(drow0 + nl, dcol0 + k0 + kq * 16, ldd);
    *(u32x4*)d = (u32x4){w[0], w[1], w[2], w[3]};
    *(u32x4*)(d + 8) = (u32x4){w[4], w[5], w[6], w[7]};
    if (shp) {
#pragma unroll
        for (int cr = 0; cr < 3; ++cr) {
            float a = 0.f;
#pragma unroll
            for (int q4 = 0; q4 < 4; ++q4) {
                const f32x4 s4 = *(const f32x4*)(SH + cr * 64 + kq * 16 + q4 * 4);
                a += s4[0] * tv[q4 * 4] + s4[1] * tv[q4 * 4 + 1] + s4[2] * tv[q4 * 4 + 2] + s4[3] * tv[q4 * 4 + 3];
            }
            a += __shfl_xor(a, 1); a += __shfl_xor(a, 2);
            if (kq == 0) atomicAdd((int*)biasp + cr * NBIAS + drow0 + nl, (int)lrintf(a * BIAS_SCALE));
        }
    }
    __syncthreads();
}

DI void prologue_transpose(const Ctx& cx, const Params& p, int u, unsigned char* smem) {
    const int l = u / 4816; int i = u % 4816;
    if (i < 1920) { const int kt = i & 15, nt = i >> 4;
        transpose_tile(cx, p.w_in + (size_t)l * DM * NIN, NIN, kt * 64, nt * 64, ((bf16_t*)(p.ws + OFF_WinT)) + (size_t)l * NIN * DM, DM, 0, nt * 64, smem,
                       ((float*)(p.ws + OFF_mod)) + (size_t)l * 3 * 6144, ((float*)(p.ws + OFF_bias)) + (size_t)l * 3 * NBIAS); return; }
    i -= 1920;
    if (i < 512) { const int brn = i >> 7; const int j = i & 127; const int kt = j & 7, nt = j >> 3;
        transpose_tile(cx, p.w_br + ((size_t)l * 4 + brn) * 512 * DM, DM, kt * 64, nt * 64, ((bf16_t*)(p.ws + OFF_WbrT)) + (size_t)l * DM * 2048, 2048, brn * 512, nt * 64, smem); return; }
    i -= 512;
    if (i < 256) { const int kt = i & 15, nt = i >> 4;
        transpose_tile(cx, p.w_o + (size_t)l * DM * DM, DM, kt * 64, nt * 64, ((bf16_t*)(p.ws + OFF_WoT)) + (size_t)l * DM * DM, DM, 0, nt * 64, smem); return; }
    i -= 256;
    if (i < 1408) { const int kt = i & 15, nt = i >> 4;
        const int isb = nt >= 44; const int j0 = (nt - (isb ? 44 : 0)) * 64;
        float* T = (float*)smem;
        const int tid = cx.tid; const int kk = tid >> 4, c4 = (tid & 15) * 4;
        const float* src = p.w_gu + (size_t)l * DM * 2 * DFF;
        f32x4 v[4];
#pragma unroll
        for (int q = 0; q < 4; ++q) v[q] = __builtin_nontemporal_load((const f32x4*)(src + (size_t)(kt * 64 + kk + 16 * q) * (2 * DFF) + nt * 64 + c4));
        __builtin_amdgcn_sched_barrier(0);
#pragma unroll
        for (int q = 0; q < 4; ++q) {
            float* t = T + (kk + 16 * q) * 65 + c4;
            t[0] = v[q][0]; t[1] = v[q][1]; t[2] = v[q][2]; t[3] = v[q][3];
        }
        float* SH = T + 64 * 65;
        if (tid < 192) SH[tid] = ((float*)(p.ws + OFF_mod))[(size_t)(l * 3 + (tid >> 6)) * 6144 + 3072 + kt * 64 + (tid & 63)];
        __syncthreads();
        const int nl = tid >> 2, kq = tid & 3;
        float tv[16];
#pragma unroll
        for (int j = 0; j < 16; ++j) tv[j] = T[(kq * 16 + j) * 65 + nl];
        unsigned w[8];
#pragma unroll
        for (int j = 0; j < 8; ++j) w[j] = pack2(tv[2 * j], tv[2 * j + 1]);
        const int drow = (j0 >> 5) * 64 + isb * 32 + nl + (nl >= 32 ? 32 : 0);
        bf16_t* d = ((bf16_t*)(p.ws + OFF_WguT)) + (size_t)l * 2 * DFF * DM + wtile_off(drow, kt * 64 + kq * 16, DM);
        *(u32x4*)d = (u32x4){w[0], w[1], w[2], w[3]};
        *(u32x4*)(d + 8) = (u32x4){w[4], w[5], w[6], w[7]};
        {
            const int drn = (j0 >> 5) * 64 + isb * 32 + nl + (nl >= 32 ? 32 : 0);
#pragma unroll
            for (int cr = 0; cr < 3; ++cr) {
                float a = 0.f;
#pragma unroll
                for (int q4 = 0; q4 < 4; ++q4) {
                    const f32x4 s4 = *(const f32x4*)(SH + cr * 64 + kq * 16 + q4 * 4);
                    a += s4[0] * tv[q4 * 4] + s4[1] * tv[q4 * 4 + 1] + s4[2] * tv[q4 * 4 + 2] + s4[3] * tv[q4 * 4 + 3];
                }
                a += __shfl_xor(a, 1); a += __shfl_xor(a, 2);
                if (kq == 0) atomicAdd(((int*)(p.ws + OFF_bias)) + (size_t)(l * 3 + cr) * NBIAS + NIN + drn, (int)lrintf(a * BIAS_SCALE));
            }
        }
        __syncthreads();
        return; }
    i -= 1408;
    if (i < 704) { const int kt = i % 44, nt = i / 44;
        transpose_tile(cx, p.w_down + (size_t)l * DFF * DM, DM, kt * 64, nt * 64, ((bf16_t*)(p.ws + OFF_WdT)) + (size_t)l * DM * DFF, DFF, 0, nt * 64, smem); return; }
    i -= 704;
    { const int g = i >> 2; const int kt = i & 1, nt = (i >> 1) & 1;
        transpose_tile(cx, p.pool_w + ((size_t)l * 4 + g) * 128 * 128, 128, kt * 64, nt * 64, ((bf16_t*)(p.ws + OFF_PoolT)) + ((size_t)l * 4 + g) * 128 * 128, 128, 0, nt * 64, smem); }
}

DI void prologue_mod(const Ctx& cx, const Params& p, int u, unsigned char* smem) {
    const int l = u / 96, chunk = u % 96;
    const int tid = cx.tid, cgp = tid & 15, ks = tid >> 4;
    float* S = (float*)smem;
    float* red = S + 3 * 1024;
#pragma unroll
    for (int j = 0; j < 4; ++j) {
        const int k = tid + 256 * j;
        const float c0 = p.c_ctx[k], c1 = p.c[k], c2 = p.c[DM + k];
        S[k] = c0 / (1.f + __expf(-c0)); S[1024 + k] = c1 / (1.f + __expf(-c1)); S[2048 + k] = c2 / (1.f + __expf(-c2));
    }
    __syncthreads();
    const float* w = p.w_mod + (size_t)l * DM * 6144 + chunk * 64 + cgp * 4;
    float a[3][4];
#pragma unroll
    for (int r = 0; r < 3; ++r)
#pragma unroll
        for (int j = 0; j < 4; ++j) a[r][j] = 0.f;
#pragma unroll 1
    for (int kb = 0; kb < 64; kb += 16) {
        f32x4 wv[16];
#pragma unroll
        for (int q = 0; q < 16; ++q) wv[q] = __builtin_nontemporal_load((const f32x4*)(w + (size_t)(ks * 64 + kb + q) * 6144));
        __builtin_amdgcn_sched_barrier(0);
#pragma unroll
        for (int q = 0; q < 16; ++q) {
            const int k = ks * 64 + kb + q;
            const float s0 = S[k], s1 = S[1024 + k], s2 = S[2048 + k];
#pragma unroll
            for (int j = 0; j < 4; ++j) { a[0][j] += s0 * wv[q][j]; a[1][j] += s1 * wv[q][j]; a[2][j] += s2 * wv[q][j]; }
        }
    }
#pragma unroll
    for (int r = 0; r < 3; ++r)
#pragma unroll
        for (int j = 0; j < 4; ++j) red[(ks * 3 + r) * 64 + cgp * 4 + j] = a[r][j];
    __syncthreads();
    if (tid < 192) {
        const int r = tid >> 6, nn = tid & 63;
        float v = p.b_mod[l * 6144 + chunk * 64 + nn];
#pragma unroll
        for (int q = 0; q < 16; ++q) v += red[(q * 3 + r) * 64 + nn];
        ((float*)(p.ws + OFF_mod))[(size_t)(l * 3 + r) * 6144 + chunk * 64 + nn] = v;
    }
    __syncthreads();
}

DI void prologue_misc(const Ctx& cx, const Params& p, int u) {
    const int tid = cx.tid;
    if (u < 768) {
        const f32x4* a = (const f32x4*)p.x_prompt; const f32x4* b = (const f32x4*)p.x_sample; f32x4* o = (f32x4*)p.out;
#pragma unroll
        for (int j = 0; j < 8; ++j) { const int idx = u * 2048 + tid + 256 * j; o[idx] = __builtin_nontemporal_load(idx < 1048576 ? a + idx : b + (idx - 1048576)); }
        return;
    }
    u -= 768;
    if (u < 512) {
        const int e = (u * 256 + tid) * 8;
        const int which = e >> 19, rem = e & ((1 << 19) - 1);
        const int b = rem >> 18, l = (rem >> 16) & 3, s = (rem >> 7) & 511, c = rem & 127;
        const float* src = (which ? p.ck_w : p.ck_a) + rem;
        const f32x4 v0 = __builtin_nontemporal_load((const f32x4*)src), v1 = __builtin_nontemporal_load((const f32x4*)(src + 4));
        bf16_t* dst = (which ? ((bf16_t*)(p.ws + OFF_kCl)) : ((bf16_t*)(p.ws + OFF_kAl))) + ((size_t)((l * 2 + b) * 1536 + s)) * 128 + c;
        *(u32x4*)dst = (u32x4){pack2(v0[0], v0[1]), pack2(v0[2], v0[3]), pack2(v1[0], v1[1]), pack2(v1[2], v1[3])};
        return;
    }
    u -= 512;
    if (u < 64) {
        const int which = u >> 5, l = (u >> 3) & 3, b = (u >> 2) & 1, sp = u & 3;
        const int col = tid & 127, s0 = (sp * 2 + (tid >> 7)) * 64;
        const float* src = (which ? p.cv_w : p.cv_a) + ((size_t)((b * 4 + l) * 512 + s0)) * 128 + col;
        bf16_t* dst = (which ? ((bf16_t*)(p.ws + OFF_vClT)) : ((bf16_t*)(p.ws + OFF_vAlT))) + ((size_t)((l * 2 + b) * 128 + col)) * 1536 + s0;
        float v[64];
#pragma unroll
        for (int j = 0; j < 64; ++j) v[j] = __builtin_nontemporal_load(src + (size_t)j * 128);
        __builtin_amdgcn_sched_barrier(0);
#pragma unroll
        for (int jc = 0; jc < 8; ++jc)
            *(u32x4*)(dst + jc * 8) = (u32x4){pack2(v[jc * 8 + 0], v[jc * 8 + 1]), pack2(v[jc * 8 + 2], v[jc * 8 + 3]), pack2(v[jc * 8 + 4], v[jc * 8 + 5]), pack2(v[jc * 8 + 6], v[jc * 8 + 7])};
        return;
    }
    u -= 64;
    if (u < 51) {
        f32x4* z = (f32x4*)(p.ws + OFF_ssq);
        const int n4 = (int)((WS_TOTAL - OFF_ssq) / 16);
        const float zf = __int_as_float(tid >> 20);
#pragma unroll
        for (int j = 0; j < 4; ++j) { const int idx = u * 1024 + tid + 256 * j; if (idx < n4) z[idx] = (f32x4){zf, zf, zf, zf}; }
        return;
    }
    u -= 51;
    {
#pragma unroll
        for (int j = 0; j < 4; ++j) {
            const int idx = tid + 256 * j; const int pos = idx >> 4, i = idx & 15;
            const float inv = 1.0f / powf(10000.0f, (float)i / 16.0f);
            const float ang = (float)pos * inv;
            ((float*)(p.ws + OFF_rope))[idx] = cosf(ang); ((float*)(p.ws + OFF_rope))[1024 + idx] = sinf(ang);
        }
    }
}
constexpr int PRO_T = 4816, PRO_MOD = 96 * NL, PRO_MISC = 768 + 512 + 64 + 51 + 1;

DI void x0_rows(const Ctx& cx, const Params& p, int r0, int rstride) {
    const int lane = cx.tid & 63;
    f32x4 v[3][4];
#pragma unroll
    for (int q = 0; q < 3; ++q) {
        const f32x4* x = (const f32x4*)(p.out + (size_t)(r0 + q * rstride) * DM);
#pragma unroll
        for (int i = 0; i < 4; ++i) v[q][i] = x[lane + 64 * i];
    }
    f32x4 gv[4];
#pragma unroll
    for (int i = 0; i < 4; ++i) gv[i] = *(const f32x4*)(p.g_mix + (lane + 64 * i) * 4);
    f32x4 scv[3][4];
#pragma unroll
    for (int q = 0; q < 3; ++q)
#pragma unroll
        for (int i = 0; i < 4; ++i) scv[q][i] = *(const f32x4*)(((float*)(p.ws + OFF_mod)) + (size_t)condrow(r0 + q * rstride) * 6144 + DM + (lane + 64 * i) * 4);
    __builtin_amdgcn_sched_barrier(0);
#pragma unroll
    for (int q = 0; q < 3; ++q) {
        const int r = r0 + q * rstride;
        float a = 0.f;
#pragma unroll
        for (int i = 0; i < 4; ++i) a += v[q][i][0] * v[q][i][0] + v[q][i][1] * v[q][i][1] + v[q][i][2] * v[q][i][2] + v[q][i][3] * v[q][i][3];
        a = wave_sum(a);
        if (lane == 0) ((unsigned*)(p.ws + OFF_ssq))[r] = (unsigned)(a * SSQ_SCALE + 0.5f);
#pragma unroll
        for (int i = 0; i < 4; ++i) {
            const int c = (lane + 64 * i) * 4;
            const f32x4 sc = scv[q][i];
            float o[4];
#pragma unroll
            for (int j = 0; j < 4; ++j) o[j] = v[q][i][j] * gv[i][j] * (1.f + sc[j]);
            *(u32x2*)(((bf16_t*)(p.ws + OFF_h)) + wtile_off(r, c, DM)) = (u32x2){pack2(o[0], o[1]), pack2(o[2], o[3])};
        }
    }
}

enum { E_IN = 0, E_BR = 1, E_RES = 2, E_GU = 3, E_POOL = 4 };
struct GemmArgs { const bf16_t* A; int lda; const bf16_t* Bt; int ldb; int K; int row0, col0; int layer; int aux; int atk; };
constexpr int STG_B = 16384;
#define GL_WAIT(n) asm volatile("s_waitcnt vmcnt(" #n ")" ::: "memory")
#define GL_BAR() do { asm volatile("s_waitcnt lgkmcnt(0)" ::: "memory"); __builtin_amdgcn_s_barrier(); } while (0)

template <int EPI> DI void gemm_tile(const Ctx& cx, const Params& p, const GemmArgs& g, unsigned char* smem, bool pre, bool hn, const GemmArgs& gn) {
    const int tid = cx.tid, wid = tid >> 6, lane = tid & 63, l31 = lane & 31, hh = lane >> 5, wm = wid >> 1, wn = wid & 1;
    f32x16 acc[2][2], tot[2][2];
#pragma unroll
    for (int a = 0; a < 2; ++a)
#pragma unroll
        for (int b = 0; b < 2; ++b)
#pragma unroll
            for (int r = 0; r < 16; ++r) { acc[a][b][r] = 0.f; tot[a][b][r] = 0.f; }
    float rs[2][16]; float bcol[2]; float sraw = 0.f;
    if (EPI == E_IN || EPI == E_GU) {
        if (tid < 128) sraw = ((const float*)(p.ws + OFF_ssq))[(size_t)(g.layer * 2 + (EPI == E_GU ? 1 : 0)) * NTOK + g.row0 + tid];
        const float* bp = ((float*)(p.ws + OFF_bias)) + (size_t)(g.layer * 3 + condrow(g.row0)) * NBIAS + (EPI == E_GU ? NIN : 0) + g.col0 + wn * 64 + l31;
        bcol[0] = bp[0]; bcol[1] = bp[32];
    }
    const int nk = g.K >> 5;
    const int lrow = wid * 32 + (lane >> 2);
    const int lsw = (lane & 3) ^ ((lane >> 4) & 3);
    const int lr0 = (g.aux & 16) ? 0 : g.row0, lc0 = (g.aux & 16) ? 0 : g.col0;
    const int ars = g.atk ? 32 : g.lda;
    const size_t aks = g.atk ? 4096 : 32;
    const bf16_t* Ag = g.A + (g.atk ? ((size_t)(lr0 >> 7) * g.atk) * 4096 : (size_t)lr0 * g.lda) + (size_t)lrow * ars + lsw * 8;
    const bf16_t* Bg = g.Bt + ((size_t)(g.col0 >> 7) * (g.K >> 5)) * 4096 + lrow * 32 + lsw * 8;
    const size_t a16 = (size_t)16 * g.lda, b16 = (size_t)16 * g.ldb;
    unsigned char* lbase = smem + wid * 2048;
    auto issue = [&](int kt, int buf) {
        unsigned char* d = lbase + buf * STG_B;
        __builtin_amdgcn_global_load_lds((const unsigned*)(Ag + kt * aks), (unsigned*)d, 16, 0, 0);
        __builtin_amdgcn_global_load_lds((const unsigned*)(Ag + 16 * ars + kt * aks), (unsigned*)(d + 1024), 16, 0, 0);
        __builtin_amdgcn_global_load_lds((const unsigned*)(Bg + (size_t)kt * 4096), (unsigned*)(d + 8192), 16, 0, 0);
        __builtin_amdgcn_global_load_lds((const unsigned*)(Bg + (size_t)kt * 4096 + 512), (unsigned*)(d + 8192 + 1024), 16, 0, 0);
    };
    const int sw = (l31 >> 2) & 3;
    const int offA = (wm * 64 + l31) * 64, offB = 8192 + (wn * 64 + l31) * 64;
    const int c0 = ((0 + hh) ^ sw) * 16, c1 = ((2 + hh) ^ sw) * 16;
    if (!pre) { issue(0, 0); issue(1, 1); issue(2, 2); }
    for (int kt0 = 0; kt0 < nk; kt0 += 4) {
#pragma unroll
        for (int u = 0; u < 4; ++u) {
            const int kt = kt0 + u;
            if (pre && kt == 0) GL_WAIT(0);
            else if (kt + 2 < nk) GL_WAIT(8); else if (kt + 1 < nk) GL_WAIT(4); else GL_WAIT(0);
            GL_BAR();
            const unsigned char* sb = smem + u * STG_B;
            const bf16x8 a00 = *(const bf16x8*)(sb + offA + c0), a10 = *(const bf16x8*)(sb + offA + 2048 + c0);
            const bf16x8 b00 = *(const bf16x8*)(sb + offB + c0), b10 = *(const bf16x8*)(sb + offB + 2048 + c0);
            const bf16x8 a01 = *(const bf16x8*)(sb + offA + c1), a11 = *(const bf16x8*)(sb + offA + 2048 + c1);
            const bf16x8 b01 = *(const bf16x8*)(sb + offB + c1), b11 = *(const bf16x8*)(sb + offB + 2048 + c1);
            __builtin_amdgcn_sched_barrier(0);
            if (kt + 3 < nk) issue(kt + 3, (u + 3) & 3);
            __builtin_amdgcn_sched_barrier(0);
            acc[0][0] = __builtin_amdgcn_mfma_f32_32x32x16_bf16(a00, b00, acc[0][0], 0, 0, 0);
            acc[0][1] = __builtin_amdgcn_mfma_f32_32x32x16_bf16(a00, b10, acc[0][1], 0, 0, 0);
            acc[1][0] = __builtin_amdgcn_mfma_f32_32x32x16_bf16(a10, b00, acc[1][0], 0, 0, 0);
            acc[1][1] = __builtin_amdgcn_mfma_f32_32x32x16_bf16(a10, b10, acc[1][1], 0, 0, 0);
            acc[0][0] = __builtin_amdgcn_mfma_f32_32x32x16_bf16(a01, b01, acc[0][0], 0, 0, 0);
            acc[0][1] = __builtin_amdgcn_mfma_f32_32x32x16_bf16(a01, b11, acc[0][1], 0, 0, 0);
            acc[1][0] = __builtin_amdgcn_mfma_f32_32x32x16_bf16(a11, b01, acc[1][0], 0, 0, 0);
            acc[1][1] = __builtin_amdgcn_mfma_f32_32x32x16_bf16(a11, b11, acc[1][1], 0, 0, 0);
        }
        if (EPI == E_BR && (kt0 & 15) == 12) {
            const int kbr = kt0 >> 4;
            const bf16_t* gp = ((bf16_t*)(p.ws + OFF_gates)) + (size_t)(((g.row0 >> 7) * 4 + kbr) * 8 + (g.col0 >> 7)) * 16384 + tid * 8;
#pragma unroll
            for (int mi = 0; mi < 2; ++mi) {
                u32x4 gw[4];
#pragma unroll
                for (int q = 0; q < 4; ++q) gw[q] = __builtin_nontemporal_load((const u32x4*)(gp + (mi * 4 + q) * 2048));
#pragma unroll
                for (int ni = 0; ni < 2; ++ni)
#pragma unroll
                    for (int r = 0; r < 16; ++r) {
                        const unsigned w = gw[ni * 2 + (r >> 3)][(r & 7) >> 1];
                        const float gv = (r & 1) ? __uint_as_float(w & 0xffff0000u) : __uint_as_float(w << 16);
                        tot[mi][ni][r] += gv * acc[mi][ni][r]; acc[mi][ni][r] = 0.f;
                    }
            }
        }
    }
    if ((EPI == E_IN || EPI == E_GU) && tid < 128)
        ((float*)(smem + 69632))[tid] = rsqrtf((float)__float_as_uint(sraw) * (SSQ_INV / DM) + 1e-6f);
    GL_BAR();
    if (hn) {
        const bf16_t* An = gn.A + (gn.atk ? ((size_t)(gn.row0 >> 7) * gn.atk) * 4096 : (size_t)gn.row0 * gn.lda) + (size_t)lrow * ars + lsw * 8;
        const bf16_t* Bn = gn.Bt + ((size_t)(gn.col0 >> 7) * (gn.K >> 5)) * 4096 + lrow * 32 + lsw * 8;
#pragma unroll
        for (int st = 0; st < 3; ++st) {
            unsigned char* d = lbase + st * STG_B;
            __builtin_amdgcn_global_load_lds((const unsigned*)(An + st * aks), (unsigned*)d, 16, 0, 0);
            __builtin_amdgcn_global_load_lds((const unsigned*)(An + 16 * ars + st * aks), (unsigned*)(d + 1024), 16, 0, 0);
            __builtin_amdgcn_global_load_lds((const unsigned*)(Bn + (size_t)st * 4096), (unsigned*)(d + 8192), 16, 0, 0);
            __builtin_amdgcn_global_load_lds((const unsigned*)(Bn + (size_t)st * 4096 + 512), (unsigned*)(d + 8192 + 1024), 16, 0, 0);
        }
    }
    if (EPI == E_IN || EPI == E_GU) {
#pragma unroll
        for (int mi = 0; mi < 2; ++mi)
#pragma unroll
            for (int r4 = 0; r4 < 4; ++r4) {
                const f32x4 q4 = *(const f32x4*)((const float*)(smem + 69632) + wm * 64 + mi * 32 + 8 * r4 + 4 * hh);
                rs[mi][4 * r4 + 0] = q4[0]; rs[mi][4 * r4 + 1] = q4[1]; rs[mi][4 * r4 + 2] = q4[2]; rs[mi][4 * r4 + 3] = q4[3];
            }
        bcol[0] = (float)__float_as_int(bcol[0]) * BIAS_INV; bcol[1] = (float)__float_as_int(bcol[1]) * BIAS_INV;
    }
    if (EPI == E_IN && g.col0 >= NPR) {
        const int gc = g.col0 - NPR;
        bf16_t* gp = ((bf16_t*)(p.ws + OFF_gates)) + (size_t)(((g.row0 >> 7) * 4 + (gc >> 10)) * 8 + ((gc & 1023) >> 7)) * 16384 + tid * 8;
#pragma unroll
        for (int mi = 0; mi < 2; ++mi)
#pragma unroll
            for (int ni = 0; ni < 2; ++ni) {
                float sg[16]; f32x16 xv;
#pragma unroll
                for (int r = 0; r < 16; ++r) xv[r] = acc[mi][ni][r] * rs[mi][r] + bcol[ni];
                sigmoid16(xv, sg);
                *(u32x4*)(gp + ((mi * 2 + ni) * 2) * 2048) = (u32x4){pack2(sg[0], sg[1]), pack2(sg[2], sg[3]), pack2(sg[4], sg[5]), pack2(sg[6], sg[7])};
                *(u32x4*)(gp + ((mi * 2 + ni) * 2 + 1) * 2048) = (u32x4){pack2(sg[8], sg[9]), pack2(sg[10], sg[11]), pack2(sg[12], sg[13]), pack2(sg[14], sg[15])};
            }
        return;
    }
    if (EPI == E_IN || EPI == E_GU || EPI == E_BR) {
        constexpr int OW = (EPI == E_GU) ? 64 : 128;
        constexpr int OS = OW + 8;
        constexpr int NH = (EPI == E_GU) ? 1 : 2;
        constexpr int RH = 128 / NH;
        constexpr int CPR = OW / 8;
        constexpr int OLD = (EPI == E_GU) ? DFF : (EPI == E_BR) ? DM : NPR;
        bf16_t* T = (bf16_t*)(smem + 3 * STG_B);
        bf16_t* O = (EPI == E_GU) ? ((bf16_t*)(p.ws + OFF_act)) + (size_t)g.row0 * DFF + (g.col0 >> 1)
                  : (EPI == E_BR) ? ((bf16_t*)(p.ws + OFF_merged)) + (size_t)g.row0 * DM + g.col0
                                  : ((bf16_t*)(p.ws + OFF_P)) + (size_t)g.row0 * NPR + g.col0;
#pragma unroll
        for (int hf = 0; hf < NH; ++hf) {
            if (NH == 1 || wm == hf) {
#pragma unroll
                for (int mi = 0; mi < 2; ++mi) {
                    float sg[16];
                    if (EPI == E_GU) {
                        f32x16 av;
#pragma unroll
                        for (int r = 0; r < 16; ++r) av[r] = acc[mi][0][r] * rs[mi][r] + bcol[0];
                        sigmoid16(av, sg);
#pragma unroll
                        for (int r = 0; r < 16; ++r) sg[r] = av[r] * sg[r] * (acc[mi][1][r] * rs[mi][r] + bcol[1]);
                    }
#pragma unroll
                    for (int r = 0; r < 16; ++r) {
                        const int rl = (NH == 1 ? wm * 64 : 0) + mi * 32 + (r & 3) + 8 * (r >> 2) + 4 * hh;
                        if (EPI == E_GU) {
                            T[rl * OS + wn * 32 + l31] = f2bf(sg[r]);
                        } else if (EPI == E_BR) {
                            T[rl * OS + wn * 64 + l31] = f2bf(tot[mi][0][r]);
                            T[rl * OS + wn * 64 + 32 + l31] = f2bf(tot[mi][1][r]);
                        } else {
                            T[rl * OS + wn * 64 + l31] = f2bf(acc[mi][0][r] * rs[mi][r] + bcol[0]);
                            T[rl * OS + wn * 64 + 32 + l31] = f2bf(acc[mi][1][r] * rs[mi][r] + bcol[1]);
                        }
                    }
                }
            }
            GL_BAR();
#pragma unroll
            for (int i = 0; i < (RH * CPR) / 256; ++i) {
                const int ch = tid + 256 * i; const int rr = ch / CPR, cc = ch % CPR;
                bf16_t* od;
                if (EPI == E_GU) od = ((bf16_t*)(p.ws + OFF_act)) + wtile_off(g.row0 + hf * RH + rr, (g.col0 >> 1) + cc * 8, DFF);
                else if (EPI == E_BR) od = ((bf16_t*)(p.ws + OFF_merged)) + wtile_off(g.row0 + hf * RH + rr, g.col0 + cc * 8, DM);
                else od = O + (size_t)(hf * RH + rr) * OLD + cc * 8;
                *(u32x4*)od = *(const u32x4*)(T + rr * OS + cc * 8);
            }
            GL_BAR();
        }
        return;
    }
    if (EPI == E_RES) {
        const int cr = condrow(g.row0), which = g.aux & 7;
        const bool mk = (which == 2) || (g.layer + 1 < NL);
        const int nl = which == 2 ? g.layer : g.layer + 1;
        const float* modc = ((float*)(p.ws + OFF_mod)) + (size_t)(g.layer * 3 + cr) * 6144 + which * DM;
        float gm[2];
        gm[0] = modc[g.col0 + wn * 64 + l31]; gm[1] = modc[g.col0 + wn * 64 + 32 + l31];
        const int cq = tid & 31;
        f32x4 gn4 = (f32x4){0.f, 0.f, 0.f, 0.f};
        if (mk) {
            const f32x4 gg = *(const f32x4*)((which == 2 ? p.g_ffn : p.g_mix) + nl * DM + g.col0 + cq * 4);
            const f32x4 sc = *(const f32x4*)(((float*)(p.ws + OFF_mod)) + (size_t)(nl * 3 + cr) * 6144 + (which == 2 ? 4 : 1) * DM + g.col0 + cq * 4);
            gn4 = gg * (1.f + sc);
        }
        unsigned* ssq = ((unsigned*)(p.ws + OFF_ssq)) + (size_t)(nl * 2 + (which == 2 ? 1 : 0)) * NTOK;
        float* Dl = (float*)smem;
#pragma unroll
        for (int mi = 0; mi < 2; ++mi) {
            f32x4 xo[8];
#pragma unroll
            for (int i = 0; i < 8; ++i) {
                const int rr = (tid >> 5) + 8 * i;
                xo[i] = *(const f32x4*)((const float*)(p.out) + (size_t)(g.row0 + (rr >> 5) * 64 + mi * 32 + (rr & 31)) * DM + g.col0 + cq * 4);
            }
#pragma unroll
            for (int r = 0; r < 16; ++r) {
                const int rl = wm * 32 + (r & 3) + 8 * (r >> 2) + 4 * hh;
                Dl[rl * 132 + wn * 64 + l31] = gm[0] * acc[mi][0][r];
                Dl[rl * 132 + wn * 64 + 32 + l31] = gm[1] * acc[mi][1][r];
            }
            GL_BAR();
#pragma unroll
            for (int i = 0; i < 8; ++i) {
                const int rr = (tid >> 5) + 8 * i;
                const int row = g.row0 + (rr >> 5) * 64 + mi * 32 + (rr & 31);
                const f32x4 xn = xo[i] + *(const f32x4*)(Dl + rr * 132 + cq * 4);
                if (mk) *(f32x4*)((float*)(p.out) + (size_t)row * DM + g.col0 + cq * 4) = xn;
                else __builtin_nontemporal_store(xn, (f32x4*)((float*)(p.out) + (size_t)row * DM + g.col0 + cq * 4));
                if (mk) {
                    const f32x4 hv = xn * gn4;
                    *(u32x2*)(((bf16_t*)(p.ws + OFF_h)) + wtile_off(row, g.col0 + cq * 4, DM)) = (u32x2){pack2(hv[0], hv[1]), pack2(hv[2], hv[3])};
                    float sq = xn[0] * xn[0] + xn[1] * xn[1] + xn[2] * xn[2] + xn[3] * xn[3];
#pragma unroll
                    for (int o2 = 16; o2 >= 1; o2 >>= 1) sq += __shfl_xor(sq, o2);
                    if (cq == 0) atomicAdd(ssq + row, (unsigned)(sq * SSQ_SCALE + 0.5f));
                }
            }
            GL_BAR();
        }
        return;
    }
#pragma unroll
    for (int mi = 0; mi < 2; ++mi)
#pragma unroll
        for (int r = 0; r < 16; ++r) {
            const int row = g.row0 + wm * 64 + mi * 32 + (r & 3) + 8 * (r >> 2) + 4 * hh;
            if (EPI == E_GU) {
                const float a = acc[mi][0][r], b = acc[mi][1][r];
                const int ac = ((g.col0 + wn * 64) >> 1) + l31;
                ((bf16_t*)(p.ws + OFF_act))[(size_t)row * DFF + ac] = f2bf(a / (1.f + __expf(-a)) * b);
            } else {
#pragma unroll
                for (int ni = 0; ni < 2; ++ni) {
                    const int col = g.col0 + wn * 64 + ni * 32 + l31;
                    const float v = acc[mi][ni][r];
                    if (EPI == E_IN) {
                        ((float*)(p.ws + OFF_P))[(size_t)row * NPR + col] = v;
                    } else if (EPI == E_BR) {
                        ((bf16_t*)(p.ws + OFF_merged))[(size_t)row * DM + col] = f2bf(tot[mi][ni][r]);
                    } else if (EPI == E_RES) {
                        const float gm = ((float*)(p.ws + OFF_mod))[(size_t)(g.layer * 3 + condrow(row)) * 6144 + (g.aux & 7) * DM + col];
                        __attribute__((address_space(1))) float* o = p.out + (size_t)row * DM + col;
                        if (!(g.aux & 8)) *o = *o + gm * v;
                    } else if (EPI == E_POOL) {
                        ((bf16_t*)(p.ws + OFF_br))[wtile_off(row, 1536 + g.aux * 128 + col, 2048)] = f2bf(v * p.pool_scale[g.layer * 512 + g.aux * 128 + col]);
                    }
                }
            }
        }
}

template <int EPI> DI void gemm_phase(const Ctx& cx, const Params& p, int layer, const bf16_t* A, int lda, const bf16_t* Bt, int ldb, int K, int N, int aux, unsigned char* smem) {
    const int nM = NTOK / 128, nN = N / 128;
    const int x = cx.bid & 7, j = cx.bid >> 3, J = gridDim.x >> 3;
    GemmArgs g; g.A = A; g.lda = lda; g.Bt = Bt; g.ldb = ldb; g.K = K; g.layer = layer; g.aux = aux; g.atk = K >> 5;
    if (nN == 8) {
        for (int t = j; t < (nM / 8) * 8; t += J) {
            g.row0 = ((t >> 3) * 8 + x) * 128; g.col0 = (t & 7) * 128;
            gemm_tile<EPI>(cx, p, g, smem, false, false, g);
        }
        return;
    }
    const int SN = J >> 3;
    const int nSM = nM / 8, nSN = (nN + SN - 1) / SN;
    GemmArgs gnx = g;
    int st = x; bool have = false;
    for (; st < nSM * nSN; st += 8) { const int pn = (st / nSM) * SN + (j >> 3); if (pn < nN) { g.row0 = ((st % nSM) * 8 + (j & 7)) * 128; g.col0 = pn * 128; have = true; st += 8; break; } }
    bool pre = false;
    while (have) {
        bool hn = false;
        for (; st < nSM * nSN; st += 8) { const int pn = (st / nSM) * SN + (j >> 3); if (pn < nN) { gnx.row0 = ((st % nSM) * 8 + (j & 7)) * 128; gnx.col0 = pn * 128; hn = true; st += 8; break; } }
        gemm_tile<EPI>(cx, p, g, smem, pre, hn, gnx);
        pre = hn; have = hn; g.row0 = gnx.row0; g.col0 = gnx.col0;
    }
}

DI void post_vunit(const Ctx& cx, const Params& p, int layer, int vt) {
    const int tid = cx.tid; const int pc = tid & 63, which = (tid >> 6) & 1, th = tid >> 7, col = 2 * pc;
    const int r0 = vt * 64 + th * 32;
    const bf16_t* src = ((bf16_t*)(p.ws + OFF_P)) + (size_t)r0 * NPR + (which ? 1408 : 640) + col;
    bf16_t* dst; size_t dstride; __attribute__((address_space(1))) float* of = nullptr;
    if (r0 < NCTX) { const int b = r0 >> 8, t0 = r0 & 255;
        dst = (which ? ((bf16_t*)(p.ws + OFF_vCcT)) : ((bf16_t*)(p.ws + OFF_vAcT))) + ((size_t)(b * 128 + col)) * 256 + t0; dstride = 256;
        of = p.out + (which ? OUT_VW : OUT_VA) + ((size_t)((b * 4 + layer) * 256 + t0)) * 128 + col;
    } else { const int b = (r0 - NCTX) >> 10, t0 = (r0 - NCTX) & 1023;
        dst = (which ? ((bf16_t*)(p.ws + OFF_vClT)) : ((bf16_t*)(p.ws + OFF_vAlT))) + ((size_t)((layer * 2 + b) * 128 + col)) * 1536 + 512 + t0; dstride = 1536;
    }
    unsigned raw[32];
#pragma unroll
    for (int j = 0; j < 32; ++j) raw[j] = __builtin_nontemporal_load((const unsigned*)(src + (size_t)j * NPR));
    __builtin_amdgcn_sched_barrier(0);
    if (of) {
#pragma unroll
        for (int j = 0; j < 32; ++j) {
            typedef float f32x2 __attribute__((ext_vector_type(2)));
            __builtin_nontemporal_store((f32x2){__uint_as_float(raw[j] << 16), __uint_as_float(raw[j] & 0xffff0000u)}, (__attribute__((address_space(1))) f32x2*)(of + (size_t)j * 128));
        }
    }
#pragma unroll
    for (int jc = 0; jc < 4; ++jc) {
        unsigned lo[4], hi[4];
#pragma unroll
        for (int q = 0; q < 4; ++q) {
            const unsigned a = raw[jc * 8 + 2 * q], b2 = raw[jc * 8 + 2 * q + 1];
            lo[q] = (a & 0xffffu) | (b2 << 16);
            hi[q] = (a >> 16) | (b2 & 0xffff0000u);
        }
        *(u32x4*)(dst + jc * 8) = (u32x4){lo[0], lo[1], lo[2], lo[3]};
        *(u32x4*)(dst + dstride + jc * 8) = (u32x4){hi[0], hi[1], hi[2], hi[3]};
    }
}

DI void post_row(const Ctx& cx, const Params& p, int layer, int r) {
    const int lane = cx.tid & 63;
    const bf16_t* Pr = ((bf16_t*)(p.ws + OFF_P)) + (size_t)r * NPR;
    const bool lat = r >= NCTX;
    int b, t, T;
    if (lat) { b = (r - NCTX) >> 10; t = (r - NCTX) & 1023; T = 1024; } else { b = r >> 8; t = r & 255; T = 256; }
    const int lh = lane & 31;
    unsigned hraw[10];
#pragma unroll
    for (int hp = 0; hp < 10; ++hp) {
        const int col = hp < 4 ? hp * 128 : hp == 4 ? 512 : hp < 9 ? 768 + (hp - 5) * 128 : 1280;
        hraw[hp] = __builtin_nontemporal_load((const unsigned*)(Pr + col + 2 * lane));
    }
    float cs[2] = {1.f, 1.f}, sn[2] = {0.f, 0.f};
    if (lat) {
        const float* rp = (float*)(p.ws + OFF_rope);
        const int pos = (lh < 16) ? (t >> 6) : (t & 63); const int i0 = (2 * lh) & 15;
        cs[0] = rp[pos * 16 + i0]; cs[1] = rp[pos * 16 + i0 + 1]; sn[0] = rp[1024 + pos * 16 + i0]; sn[1] = rp[1024 + pos * 16 + i0 + 1];
        if (!(lh & 8)) { sn[0] = -sn[0]; sn[1] = -sn[1]; }
    }
    float gsel4[4][2];
    gsel4[0][0] = p.gq_a[layer * 64 + 2 * lh]; gsel4[0][1] = p.gq_a[layer * 64 + 2 * lh + 1];
    gsel4[1][0] = p.gk_a[layer * 64 + 2 * lh]; gsel4[1][1] = p.gk_a[layer * 64 + 2 * lh + 1];
    gsel4[2][0] = p.gq_c[layer * 64 + 2 * lh]; gsel4[2][1] = p.gq_c[layer * 64 + 2 * lh + 1];
    gsel4[3][0] = p.gk_c[layer * 64 + 2 * lh]; gsel4[3][1] = p.gk_c[layer * 64 + 2 * lh + 1];
#pragma unroll
    for (int hp = 0; hp < 10; ++hp) {
        const int typ = hp < 4 ? 0 : hp == 4 ? 1 : hp < 9 ? 2 : 3;
        const bool isk = typ & 1; const int which = typ >> 1;
        const float v0 = __uint_as_float(hraw[hp] << 16), v1 = __uint_as_float(hraw[hp] & 0xffff0000u);
        float ss = v0 * v0 + v1 * v1;
#pragma unroll
        for (int o = 16; o >= 1; o >>= 1) ss += __shfl_xor(ss, o);
        const float rn = rsqrtf(ss * (1.0f / 64.f) + 1e-6f);
        float y0 = v0 * rn * gsel4[typ][0], y1 = v1 * rn * gsel4[typ][1];
        if (lat) { const float p0 = __shfl_xor(y0, 8), p1 = __shfl_xor(y1, 8); y0 = y0 * cs[0] + p0 * sn[0]; y1 = y1 * cs[1] + p1 * sn[1]; }
        if (!isk) {
            const int qh0 = (which ? hp - 5 : hp) * 2;
            *(unsigned*)(((bf16_t*)(p.ws + (which ? OFF_qC : OFF_qA))) + (size_t)r * 512 + qh0 * 64 + 2 * lane) = pack2(y0 * QSCALE, y1 * QSCALE);
        } else if (!lat) {
            *(unsigned*)(((bf16_t*)(p.ws + (which ? OFF_kCc : OFF_kAc))) + (size_t)r * 128 + 2 * lane) = pack2(y0, y1);
            __attribute__((address_space(1))) float* ok = p.out + (which ? OUT_KW : OUT_KA) + ((size_t)((b * 4 + layer) * 256 + t)) * 128 + 2 * lane;
            __builtin_nontemporal_store(y0, ok); __builtin_nontemporal_store(y1, ok + 1);
        } else {
            *(unsigned*)(((bf16_t*)(p.ws + (which ? OFF_kCl : OFF_kAl))) + ((size_t)((layer * 2 + b) * 1536 + 512 + t)) * 128 + 2 * lane) = pack2(y0, y1);
        }
    }
    asm volatile("" ::: "memory");
    const float mm = (t > 0) ? 1.f : 0.f, mp = (t < T - 1) ? 1.f : 0.f;
    const bf16_t* Pm = Pr - ((t > 0) ? NPR : 0);
    const bf16_t* Pp = Pr + ((t < T - 1) ? NPR : 0);
    const float* cw = p.conv_w + layer * 3 * 512;
#pragma unroll
    for (int half = 0; half < 2; ++half) {
        float yc[2][2], ym[2][2];
#pragma unroll
        for (int ii = 0; ii < 2; ++ii) {
            const int i = half * 2 + ii;
            const int c = i * 128 + 2 * lane;
            const unsigned gc0 = *(const unsigned*)(Pr + 2560 + c), u0 = *(const unsigned*)(Pr + 1536 + c);
            const unsigned gcm = *(const unsigned*)(Pm + 2560 + c), um = *(const unsigned*)(Pm + 1536 + c);
            const unsigned gcp = *(const unsigned*)(Pp + 2560 + c), up = *(const unsigned*)(Pp + 1536 + c);
            const unsigned gb = __builtin_nontemporal_load((const unsigned*)(Pr + 2048 + c));
            const float w0[2] = {cw[c], cw[c + 1]}, w1[2] = {cw[512 + c], cw[512 + c + 1]}, w2[2] = {cw[1024 + c], cw[1024 + c + 1]};
            const int hw = 1 << i;
            int lo = t - hw; lo = lo < 0 ? 0 : lo;
            int hi = t + hw; hi = hi > T ? T : hi;
            float sacc[2] = {0.f, 0.f}; unsigned pf = 0u;
#pragma unroll
            for (int q = -hw; q < hw; ++q) {
                const int tq = t + q; const bool ok = tq >= 0 && tq < T;
                const int dq = ok ? q : 0;
                const unsigned w = *(const unsigned*)(Pr + (ptrdiff_t)dq * NPR + 3072 + c);
                const float okf = ok ? 1.f : 0.f;
                sacc[0] += __uint_as_float(w << 16) * okf; sacc[1] += __uint_as_float(w & 0xffff0000u) * okf;
                if (q == 0) pf = w;
            }
            const float rn = 1.0f / (float)(hi - lo);
#pragma unroll
            for (int e = 0; e < 2; ++e) {
                auto sel = [&](unsigned w) { return e ? __uint_as_float(w & 0xffff0000u) : __uint_as_float(w << 16); };
                const float z0 = sel(gc0) * sel(u0), zm = sel(gcm) * sel(um) * mm, zp = sel(gcp) * sel(up) * mp;
                yc[ii][e] = sel(gb) * (zm * w0[e] + z0 * w1[e] + zp * w2[e]);
                ym[ii][e] = sacc[e] * rn - sel(pf);
            }
        }
#pragma unroll
        for (int ii = 0; ii < 2; ++ii) {
            const int c = (half * 2 + ii) * 128 + 2 * lane;
            *(unsigned*)(((bf16_t*)(p.ws + OFF_br)) + wtile_off(r, 512 + c, 2048)) = pack2(yc[ii][0], yc[ii][1]);
            *(unsigned*)(((bf16_t*)(p.ws + OFF_ypool)) + (size_t)r * 512 + c) = pack2(ym[ii][0], ym[ii][1]);
        }
        asm volatile("" ::: "memory");
    }
}

constexpr int KSTR = 72, VSTR = 68;
constexpr int ATT_BUF_E = 64 * KSTR + 64 * VSTR;
DI void attn_unit(const Ctx& cx, const Params& p, int layer, int kind, int b, int head, int qb, unsigned char* smem) {
    const int tid = cx.tid, wid = tid >> 6, lane = tid & 63, ql = lane & 31, hh = lane >> 5;
    const bool isC = kind & 1, isLat = kind >= 2;
    const int kvh = head >> 2;
    const int qrow = (isLat ? NCTX + b * 1024 : b * 256) + qb * 128 + wid * 32 + ql;
    const bf16_t* Kp; const bf16_t* Vt; int S;
    if (!isLat) { S = 256; Kp = (isC ? ((bf16_t*)(p.ws + OFF_kCc)) : ((bf16_t*)(p.ws + OFF_kAc))) + (size_t)b * 256 * 128 + kvh * 64; Vt = (isC ? ((bf16_t*)(p.ws + OFF_vCcT)) : ((bf16_t*)(p.ws + OFF_vAcT))) + (size_t)((b * 2 + kvh) * 64) * 256; }
    else { S = 1536; Kp = (isC ? ((bf16_t*)(p.ws + OFF_kCl)) : ((bf16_t*)(p.ws + OFF_kAl))) + (size_t)((layer * 2 + b) * 1536) * 128 + kvh * 64; Vt = (isC ? ((bf16_t*)(p.ws + OFF_vClT)) : ((bf16_t*)(p.ws + OFF_vAlT))) + (size_t)(((layer * 2 + b) * 2 + kvh) * 64) * 1536; }
    int nt1 = S / 64, t2lo = 0, t2hi = 0;
    if (kind == 3) { nt1 = 8; const int i0 = qb * 128; const int jlo = i0 - 128 < 0 ? 0 : i0 - 128; const int jhi = i0 + 256 > 1024 ? 1024 : i0 + 256; t2lo = 8 + (jlo >> 6); t2hi = 8 + (jhi >> 6); }
    const int ntiles = nt1 + (t2hi - t2lo);
    bf16x8 qf[4];
    { const bf16_t* q = (isC ? ((bf16_t*)(p.ws + OFF_qC)) : ((bf16_t*)(p.ws + OFF_qA))) + (size_t)qrow * 512 + head * 64 + hh * 8;
#pragma unroll
      for (int ks = 0; ks < 4; ++ks) qf[ks] = *(const bf16x8*)(q + ks * 16); }
    bf16_t* L = (bf16_t*)smem;
    const int sr = tid >> 3, scc = (tid & 7) * 8;
    u32x4 rk[2], rv[2];
    auto gload = [&](int it) {
        const int kt = it < nt1 ? it : t2lo + (it - nt1);
#pragma unroll
        for (int i = 0; i < 2; ++i) {
            rk[i] = *(const u32x4*)(Kp + (size_t)(kt * 64 + sr + 32 * i) * 128 + scc);
            rv[i] = *(const u32x4*)(Vt + (size_t)(sr + 32 * i) * S + kt * 64 + scc);
        }
    };
    auto lstore = [&](int buf) {
        bf16_t* Ks = L + buf * ATT_BUF_E; bf16_t* Vs = Ks + 64 * KSTR;
#pragma unroll
        for (int i = 0; i < 2; ++i) {
            *(u32x4*)(Ks + (sr + 32 * i) * KSTR + scc) = rk[i];
            u32x2* vd = (u32x2*)(Vs + (sr + 32 * i) * VSTR + scc);
            vd[0] = (u32x2){rv[i][0], rv[i][1]}; vd[1] = (u32x2){rv[i][2], rv[i][3]};
        }
    };
    f32x16 ot[2];
#pragma unroll
    for (int r = 0; r < 16; ++r) { ot[0][r] = 0.f; ot[1][r] = 0.f; }
    float m = -1e30f, lsum = 0.f;
    const int qpos = qb * 128 + wid * 32 + ql;
    gload(0); lstore(0); __syncthreads();
    for (int it = 0; it < ntiles; ++it) {
        const int buf = it & 1;
        if (it + 1 < ntiles) gload(it + 1);
        const bf16_t* Ks = L + buf * ATT_BUF_E; const bf16_t* Vs = Ks + 64 * KSTR;
        f32x16 st[2];
#pragma unroll
        for (int j = 0; j < 2; ++j) {
#pragma unroll
            for (int r = 0; r < 16; ++r) st[j][r] = 0.f;
#pragma unroll
            for (int ks = 0; ks < 4; ++ks) {
                const bf16x8 a = *(const bf16x8*)(Ks + (j * 32 + ql) * KSTR + ks * 16 + hh * 8);
                st[j] = __builtin_amdgcn_mfma_f32_32x32x16_bf16(a, qf[ks], st[j], 0, 0, 0);
            }
        }
        if (kind == 3 && it >= nt1) {
            const int kt = t2lo + (it - nt1);
            const int jbase = kt * 64 - 512;
#pragma unroll
            for (int j = 0; j < 2; ++j)
#pragma unroll
                for (int r = 0; r < 16; ++r) {
                    const int jp = jbase + j * 32 + (r & 3) + 8 * (r >> 2) + 4 * hh;
                    const int d = qpos - jp;
                    if (d > 128 || d < -128) st[j][r] = -1e30f;
                }
        }
        float mx = st[0][0];
#pragma unroll
        for (int j = 0; j < 2; ++j)
#pragma unroll
            for (int r = 0; r < 16; ++r) mx = fmaxf(mx, st[j][r]);
        mx = fmaxf(mx, __shfl_xor(mx, 32));
        const float mn = fmaxf(m, mx);
        const float alpha = __builtin_amdgcn_exp2f(m - mn);
        m = mn;
        float ps = 0.f;
#pragma unroll
        for (int j = 0; j < 2; ++j)
#pragma unroll
            for (int r = 0; r < 16; ++r) { const float e = __builtin_amdgcn_exp2f(st[j][r] - mn); st[j][r] = e; ps += e; }
        lsum = lsum * alpha + ps;
#pragma unroll
        for (int r = 0; r < 16; ++r) { ot[0][r] *= alpha; ot[1][r] *= alpha; }
#pragma unroll
        for (int j = 0; j < 2; ++j)
#pragma unroll
            for (int s2 = 0; s2 < 2; ++s2) {
                const u32x4 pw = (u32x4){pack2(st[j][8 * s2 + 0], st[j][8 * s2 + 1]), pack2(st[j][8 * s2 + 2], st[j][8 * s2 + 3]),
                                         pack2(st[j][8 * s2 + 4], st[j][8 * s2 + 5]), pack2(st[j][8 * s2 + 6], st[j][8 * s2 + 7])};
                const bf16x8 pf = __builtin_bit_cast(bf16x8, pw);
#pragma unroll
                for (int db = 0; db < 2; ++db) {
                    const bf16_t* vp = Vs + (db * 32 + ql) * VSTR + j * 32 + s2 * 16 + 4 * hh;
                    const s16x4 lo = *(const s16x4*)vp, hi = *(const s16x4*)(vp + 8);
                    const bf16x8 vf = __builtin_shufflevector(lo, hi, 0, 1, 2, 3, 4, 5, 6, 7);
                    ot[db] = __builtin_amdgcn_mfma_f32_32x32x16_bf16(vf, pf, ot[db], 0, 0, 0);
                }
            }
        if (it + 1 < ntiles) lstore(buf ^ 1);
        __syncthreads();
    }
    float lt = lsum + __shfl_xor(lsum, 32);
    float oscale = 1.f;
    if (isC) {
        const float sk = p.sink[layer * 8 + head] * LOG2E;
        const float mf = fmaxf(m, sk);
        oscale = __builtin_amdgcn_exp2f(m - mf);
        lt = lt * oscale + __builtin_amdgcn_exp2f(sk - mf);
    }
    const float inv = oscale / lt;
    bf16_t* o = ((bf16_t*)(p.ws + OFF_br)) + wtile_off(qrow, (isC ? 1024 : 0) + head * 64, 2048);
#pragma unroll
    for (int db = 0; db < 2; ++db)
#pragma unroll
        for (int g4 = 0; g4 < 4; ++g4) {
            const int d = db * 32 + 8 * g4 + 4 * hh;
            *(u32x2*)(o + db * 4096 + 8 * g4 + 4 * hh) = (u32x2){pack2(ot[db][4 * g4 + 0] * inv, ot[db][4 * g4 + 1] * inv), pack2(ot[db][4 * g4 + 2] * inv, ot[db][4 * g4 + 3] * inv)};
        }
}

DI void idle_transposes(const Ctx& cx, const Params& p, int layer, int part, unsigned char* smem) {
    if (layer + 1 >= NL) return;
    const int lo = part == 1 ? 0 : part == 2 ? 1640 : 2510, hi = part == 1 ? 1640 : part == 2 ? 2510 : 4816;
    unsigned* qctr = (unsigned*)(p.ws + OFF_bar) + 3856 + (layer * 4 + part) * 8;
    volatile unsigned* slot = (volatile unsigned*)(smem + 73696);
    for (;;) {
        __syncthreads();
        if (cx.tid == 0) *slot = atomicAdd(qctr, 1u);
        __syncthreads();
        const int t = (int)*slot;
        if (t >= hi - lo) break;
        prologue_transpose(cx, p, (layer + 1) * 4816 + lo + t, smem);
    }
}

DI void run_phase(const Ctx& cx, const Params& p, int ph, unsigned char* smem, int dry) {
    const int tid = cx.tid, wid = tid >> 6;
    if (ph < 2) {
        const int total = ph == 0 ? PRO_MOD + PRO_MISC + 1488 : 3328 + 512;
        for (int u = cx.bid; u < total; u += gridDim.x) {
            int ti = -1;
            if (ph == 0) {
                if (u < PRO_MOD) prologue_mod(cx, p, u, smem);
                else if (u < PRO_MOD + PRO_MISC) prologue_misc(cx, p, u - PRO_MOD);
                else { const int i = u - PRO_MOD - PRO_MISC; ti = i < 768 ? 1920 + i : 4096 + (i - 768); }
            } else {
                if (u < 3328) ti = u < 1920 ? u : 2688 + (u - 1920);
                else x0_rows(cx, p, (u - 3328) * 4 + wid, 2048);
            }
            if (ti >= 0) prologue_transpose(cx, p, ti, smem);
        }
        return;
    }
    const int layer = (ph - 2) / 7, sub = (ph - 2) % 7;
    switch (sub) {
    case 0: gemm_phase<E_IN>(cx, p, layer, ((bf16_t*)(p.ws + OFF_h)), DM, ((bf16_t*)(p.ws + OFF_WinT)) + (size_t)layer * NIN * DM, DM, DM, NPR, 0, smem); break;
    case 1: for (int u = cx.bid; u < 96 + 1536; u += gridDim.x) { if (u < 96) post_vunit(cx, p, layer, u); else post_row(cx, p, layer, (u - 96) * 4 + wid); } break;
    case 2:
        for (int u = cx.bid; u < 960; u += gridDim.x) {
            if (u < 128) attn_unit(cx, p, layer, 2, u >> 6, (u >> 3) & 7, u & 7, smem);
            else if (u < 256) { const int v = u - 128; attn_unit(cx, p, layer, 3, v >> 6, (v >> 3) & 7, v & 7, smem); }
            else if (u < 512) { const int v = u - 256; attn_unit(cx, p, layer, 0, v >> 4, (v >> 1) & 7, v & 1, smem); }
            else if (u < 768) { const int v = u - 512; attn_unit(cx, p, layer, 1, v >> 4, (v >> 1) & 7, v & 1, smem); }
            else { const int v = u - 768; const int pm = v >> 2, grp = v & 3;
                GemmArgs g; g.A = ((bf16_t*)(p.ws + OFF_ypool)) + grp * 128; g.lda = 512; g.Bt = ((bf16_t*)(p.ws + OFF_PoolT)) + (size_t)(layer * 4 + grp) * 16384; g.ldb = 128; g.K = 128; g.row0 = pm * 128; g.col0 = 0; g.layer = layer; g.aux = grp; g.atk = 0;
                gemm_tile<E_POOL>(cx, p, g, smem, false, false, g); }
        }
        if (!dry) {
            unsigned* qctr = (unsigned*)(p.ws + OFF_bar) + 3600 + (layer * 2 + dry) * 32;
            volatile unsigned* slot = (volatile unsigned*)(smem + 73696);
            GemmArgs g, gnx; g.A = (bf16_t*)(p.ws + OFF_h); g.lda = DM; g.Bt = ((bf16_t*)(p.ws + OFF_WinT)) + (size_t)layer * NIN * DM; g.ldb = DM; g.K = DM; g.layer = layer; g.aux = 0; g.atk = DM >> 5;
            gnx = g;
            __syncthreads();
            if (tid == 0) *slot = atomicAdd(qctr, 1u);
            __syncthreads();
            unsigned t = *slot; bool pre = false;
            while (t < 1536u) {
                __syncthreads();
                if (tid == 0) *slot = atomicAdd(qctr, 1u);
                __syncthreads();
                const unsigned tn = *slot;
                g.row0 = (int)(t % 48u) * 128; g.col0 = NPR + (int)(t / 48u) * 128;
                const bool hn = tn < 1536u;
                if (hn) { gnx.row0 = (int)(tn % 48u) * 128; gnx.col0 = NPR + (int)(tn / 48u) * 128; }
                gemm_tile<E_IN>(cx, p, g, smem, pre, hn, gnx);
                pre = hn; t = tn;
            }
        }
        break;
    case 3: gemm_phase<E_BR>(cx, p, layer, ((bf16_t*)(p.ws + OFF_br)), 2048, ((bf16_t*)(p.ws + OFF_WbrT)) + (size_t)layer * DM * 2048, 2048, 2048, DM, 0, smem); break;
    case 4: gemm_phase<E_RES>(cx, p, layer, ((bf16_t*)(p.ws + OFF_merged)), DM, ((bf16_t*)(p.ws + OFF_WoT)) + (size_t)layer * DM * DM, DM, DM, DM, 2, smem); break;
    case 5: gemm_phase<E_GU>(cx, p, layer, ((bf16_t*)(p.ws + OFF_h)), DM, ((bf16_t*)(p.ws + OFF_WguT)) + (size_t)layer * 2 * DFF * DM, DM, DM, 2 * DFF, 0, smem); break;
    case 6: gemm_phase<E_RES>(cx, p, layer, ((bf16_t*)(p.ws + OFF_act)), DFF, ((bf16_t*)(p.ws + OFF_WdT)) + (size_t)layer * DM * DFF, DFF, DFF, DM, 5, smem); break;
    }
    if (sub == 3 || sub == 4 || sub == 6) idle_transposes(cx, p, layer, sub == 3 ? 1 : sub == 4 ? 2 : 3, smem);
}

__global__ void __launch_bounds__(256, 2) fwd_megakernel(Params p) {
    __shared__ __attribute__((aligned(16))) unsigned char smem[73728];
#if MK_MULTI
    Ctx cx; cx.tid = threadIdx.x; cx.bid = blockIdx.x;
    run_phase(cx, p, p.phase_lo, smem, 0);
#else
    if (threadIdx.x == 0) *(uint4*)(smem + 73712) = make_uint4(0u, 0u, 0u, 0u);
    __syncthreads();
    XcdBarrier xb = xcd_barrier_post((unsigned*)(p.ws + OFF_bar), (volatile LAS unsigned*)(smem + 73712));
    if (p.phase_lo < 0) cg::this_grid().sync();
    for (int ph = p.phase_lo; ph < p.phase_hi; ++ph) {
        Ctx cx; cx.tid = threadIdx.x; cx.bid = blockIdx.x;
        asm volatile("" : "+v"(cx.tid));
        asm volatile("" : "+s"(cx.bid));
        Params q = p;
        asm volatile("" : "+s"(q.ws));
        asm volatile("" : "+s"(q.out));
        run_phase(cx, q, ph, smem, 0);
        if (ph + 1 < p.phase_hi) xcd_barrier(xb);
#if PROBE2
        if (ph >= 2) { const int sub = (ph - 2) % 7;
            if (((PROBE2 & 1) && sub == 0) || ((PROBE2 & 2) && sub == 1) || ((PROBE2 & 8) && sub == 5)) { run_phase(cx, q, ph, smem, 0); xcd_barrier(xb); }
            if ((PROBE2 & 4) && sub == 1) { run_phase(cx, q, ph + 1, smem, 1); xcd_barrier(xb); } }
#endif
    }
#endif
}

extern "C" void kernel_launch(void* const* d_in, const int* in_sizes, int n_in, void* d_out, int out_size, void* d_ws, size_t ws_size, hipStream_t stream) {
    Params p; memset(&p, 0, sizeof(p));
    const float* const* in = (const float* const*)d_in;
    p.x_prompt = in[0]; p.x_sample = in[1]; p.ck_a = in[2]; p.cv_a = in[3]; p.ck_w = in[4]; p.cv_w = in[5]; p.c = in[6]; p.c_ctx = in[7];
    p.w_mod = in[8]; p.b_mod = in[9]; p.g_mix = in[10]; p.g_ffn = in[11]; p.w_in = in[12]; p.gq_a = in[13]; p.gk_a = in[14]; p.gq_c = in[15]; p.gk_c = in[16];
    p.sink = in[17]; p.conv_w = in[18]; p.pool_w = in[19]; p.pool_scale = in[20]; p.w_br = in[21]; p.w_o = in[22]; p.w_gu = in[23]; p.w_down = in[24];
    p.out = (__attribute__((address_space(1))) float*)d_out;
    p.ws = (__attribute__((address_space(1))) unsigned char*)d_ws;
    if (WS_TOTAL > ws_size) { fprintf(stderr, "workspace too small: need %zu have %zu\n", (size_t)WS_TOTAL, ws_size); return; }
#if MK_MULTI
    for (int ph = 0; ph < NPHASE; ++ph) {
        p.phase_lo = ph; p.phase_hi = ph + 1;
        hipLaunchKernelGGL(fwd_megakernel, dim3(512), dim3(256), 0, stream, p);
    }
#else
    static int grid_blocks = 0;
    if (!grid_blocks) {
        int dev = 0, cus = 0, per_cu = 0;
        hipGetDevice(&dev);
        hipDeviceGetAttribute(&cus, hipDeviceAttributeMultiprocessorCount, dev);
        hipOccupancyMaxActiveBlocksPerMultiprocessor(&per_cu, fwd_megakernel, 256, 0);
        if (per_cu > 2) per_cu = 2;
        if (per_cu < 1) per_cu = 1;
        grid_blocks = cus * per_cu;
    }
    p.phase_lo = 0; p.phase_hi = NPHASE;
    (void)hipMemsetAsync((unsigned char*)d_ws + OFF_bar, 0, 16384, stream);
    void* args[] = {&p};
    hipError_t e = hipLaunchCooperativeKernel((void*)fwd_megakernel, dim3(grid_blocks), dim3(256), args, 0, stream);
    if (e != hipSuccess) fprintf(stderr, "cooperative launch failed: %s (grid %d)\n", hipGetErrorString(e), grid_blocks);
#endif
}
```
